# Optimizing an MI355X kernel written in HIP

```python
import jax, jax.numpy as jnp
from jax import lax
import numpy as np

D_MODEL = 1024
BATCH = 2
SEQ = 8192
DEPTH = 4

HEAD_DIM = 64
SB_HEADS = D_MODEL // 256
FOX_HEADS = D_MODEL // 128
SGU_GROUPS = D_MODEL // 256
SGU_DIM = 64
SGU_CHUNK = 128
Q_BLOCK = 128
D_FF = 4 * D_MODEL
EPS = 1e-6

SB_W = SB_HEADS * HEAD_DIM
FOX_W = FOX_HEADS * HEAD_DIM
SGU_W = SGU_GROUPS * SGU_DIM
MIX_W = SB_W + FOX_W + SGU_W
IN_SIZES = [SB_W, SB_W, SB_W, FOX_W, FOX_W, FOX_W, FOX_HEADS, SGU_W, SGU_W]
IN_W = sum(IN_SIZES)
IN_SPLITS = [int(s) for s in np.cumsum(IN_SIZES)[:-1]]

kernel_name = "hybrid_sb_fox_sgu_adaln"


def rmsnorm(x, g):
    xf = x.astype(jnp.float32)
    y = xf * lax.rsqrt(jnp.mean(xf * xf, axis=-1, keepdims=True) + EPS)
    return (y * g).astype(x.dtype)


def modulate(h, shift, scale):
    return h * (1.0 + scale[:, None, :]) + shift[:, None, :]


def split_heads(t, n_heads):
    b, s, _ = t.shape
    return t.reshape(b, s, n_heads, -1).transpose(0, 2, 1, 3)


def merge_heads(t):
    b, h, s, d = t.shape
    return t.transpose(0, 2, 1, 3).reshape(b, s, h * d)


def to_blocks(t):
    b, h, s, d = t.shape
    return jnp.moveaxis(t.reshape(b, h, s // Q_BLOCK, Q_BLOCK, d), 2, 0)


def from_blocks(o):
    n, b, h, q, d = o.shape
    return jnp.moveaxis(o, 0, 2).reshape(b, h, n * q, d)


def stick_breaking_attention(q, k, v):
    s_len = k.shape[2]
    scale = HEAD_DIM ** -0.5
    s_pos = jnp.arange(s_len)

    def block(args):
        qb, i = args
        z = jnp.einsum('bhqd,bhsd->bhqs', qb, k).astype(jnp.float32) * scale
        t_pos = i * Q_BLOCK + jnp.arange(Q_BLOCK)
        mask = s_pos[None, :] < t_pos[:, None]
        log_1mb = jnp.where(mask, jax.nn.log_sigmoid(-z), 0.0)
        between = lax.cumsum(log_1mb, axis=3, reverse=True) - log_1mb
        a = jnp.where(mask, jnp.exp(jax.nn.log_sigmoid(z) + between), 0.0)
        return jnp.einsum('bhqs,bhsd->bhqd', a.astype(v.dtype), v)

    o = lax.map(block, (to_blocks(q), jnp.arange(s_len // Q_BLOCK)))
    return from_blocks(o)


def forgetting_attention(q, k, v, log_f):
    b, h, s_len, _ = k.shape
    n_blk = s_len // Q_BLOCK
    scale = HEAD_DIM ** -0.5
    cum_f = jnp.cumsum(log_f, axis=-1)
    cum_f_blocks = jnp.moveaxis(cum_f.reshape(b, h, n_blk, Q_BLOCK), 2, 0)
    s_pos = jnp.arange(s_len)

    def block(args):
        qb, fq, i = args
        z = jnp.einsum('bhqd,bhsd->bhqs', qb, k).astype(jnp.float32) * scale
        z = z + fq[..., :, None] - cum_f[:, :, None, :]
        t_pos = i * Q_BLOCK + jnp.arange(Q_BLOCK)
        mask = s_pos[None, :] <= t_pos[:, None]
        p = jax.nn.softmax(jnp.where(mask, z, -jnp.inf), axis=-1)
        return jnp.einsum('bhqs,bhsd->bhqd', p.astype(v.dtype), v)

    o = lax.map(block, (to_blocks(q), cum_f_blocks, jnp.arange(n_blk)))
    return from_blocks(o)


def spatial_gating(u, vv, norm_g, w_s, b_s):
    b, s_len, _ = u.shape
    n_chunk = s_len // SGU_CHUNK
    vv = rmsnorm(vv.reshape(b, s_len, SGU_GROUPS, SGU_DIM), norm_g)
    vv = vv.reshape(b, n_chunk, SGU_CHUNK, SGU_GROUPS, SGU_DIM)
    w = jnp.tril(w_s)
    mixed = jnp.einsum('gts,bnsgd->bntgd', w, vv) + b_s.T[None, None, :, :, None]
    return u * mixed.reshape(b, s_len, SGU_W)


def setup_inputs(seed: int = 0) -> dict:
    key = jax.random.key(seed)
    ks = jax.random.split(key, 16)
    nrm = jax.random.normal
    f32 = jnp.float32
    return {
        "x": nrm(ks[0], (BATCH, SEQ, D_MODEL), f32),
        "c": nrm(ks[1], (BATCH, D_MODEL), f32),
        "ada_w": nrm(ks[2], (DEPTH, D_MODEL, 6 * D_MODEL), f32) * (0.5 * D_MODEL ** -0.5),
        "ada_b": nrm(ks[3], (DEPTH, 6 * D_MODEL), f32) * 0.02,
        "norm1_g": 1.0 + 0.01 * nrm(ks[4], (DEPTH, D_MODEL), f32),
        "norm2_g": 1.0 + 0.01 * nrm(ks[5], (DEPTH, D_MODEL), f32),
        "w_in": nrm(ks[6], (DEPTH, D_MODEL, IN_W), f32) * D_MODEL ** -0.5,
        "b_forget": 2.0 + 0.5 * nrm(ks[7], (DEPTH, FOX_HEADS), f32),
        "q_norm_g": 1.0 + 0.01 * nrm(ks[8], (DEPTH, HEAD_DIM), f32),
        "k_norm_g": 1.0 + 0.01 * nrm(ks[9], (DEPTH, HEAD_DIM), f32),
        "sgu_norm_g": 1.0 + 0.01 * nrm(ks[10], (DEPTH, SGU_GROUPS, SGU_DIM), f32),
        "sgu_w": nrm(ks[11], (DEPTH, SGU_GROUPS, SGU_CHUNK, SGU_CHUNK), f32) * SGU_CHUNK ** -0.5,
        "sgu_b": 1.0 + 0.1 * nrm(ks[12], (DEPTH, SGU_GROUPS, SGU_CHUNK), f32),
        "w_out": nrm(ks[13], (DEPTH, MIX_W, D_MODEL), f32) * MIX_W ** -0.5,
        "mlp_w1": nrm(ks[14], (DEPTH, D_MODEL, D_FF), f32) * D_MODEL ** -0.5,
        "mlp_w2": nrm(ks[15], (DEPTH, D_FF, D_MODEL), f32) * D_FF ** -0.5,
    }


def reference(x, c, ada_w, ada_b, norm1_g, norm2_g, w_in, b_forget, q_norm_g, k_norm_g,
              sgu_norm_g, sgu_w, sgu_b, w_out, mlp_w1, mlp_w2):
    cond = jax.nn.silu(c)
    for l in range(DEPTH):
        mod = cond @ ada_w[l] + ada_b[l]
        sh1, sc1, g1, sh2, sc2, g2 = jnp.split(mod, 6, axis=-1)

        h = modulate(rmsnorm(x, norm1_g[l]), sh1, sc1)
        proj = h @ w_in[l]
        qa, ka, va, qb, kb, vb, fl, uc, vc = jnp.split(proj, IN_SPLITS, axis=-1)

        o_sb = stick_breaking_attention(split_heads(qa, SB_HEADS), split_heads(ka, SB_HEADS),
                                        split_heads(va, SB_HEADS))

        q_fox = rmsnorm(split_heads(qb, FOX_HEADS), q_norm_g[l])
        k_fox = rmsnorm(split_heads(kb, FOX_HEADS), k_norm_g[l])
        log_f = jax.nn.log_sigmoid(fl.astype(jnp.float32) + b_forget[l].astype(jnp.float32))
        o_fox = forgetting_attention(q_fox, k_fox, split_heads(vb, FOX_HEADS),
                                     log_f.transpose(0, 2, 1))

        o_sgu = spatial_gating(jax.nn.gelu(uc), jax.nn.gelu(vc), sgu_norm_g[l], sgu_w[l], sgu_b[l])

        mixed = jnp.concatenate([merge_heads(o_sb), merge_heads(o_fox), o_sgu], axis=-1)
        x = x + g1[:, None, :] * (mixed @ w_out[l])

        h = modulate(rmsnorm(x, norm2_g[l]), sh2, sc2)
        x = x + g2[:, None, :] * (jnp.square(jax.nn.relu(h @ mlp_w1[l])) @ mlp_w2[l])
    return x
```

```cpp
#include <hip/hip_runtime.h>
#include <hip/hip_cooperative_groups.h>
#include <cstdio>
#include <cstdint>
namespace cg = cooperative_groups;
namespace pg8 {
#define PG8_LAS __attribute__((address_space(3)))
typedef unsigned short bf16_t;
typedef short bf16x8 __attribute__((ext_vector_type(8)));
typedef float f32x4 __attribute__((ext_vector_type(4)));
typedef unsigned u32x4 __attribute__((ext_vector_type(4)));
constexpr int BM = 256, BK = 64, HALF = 128, HTB = HALF * BK * 2  , STAGE_BYTES = 8 * HTB, NXCD = 8, WGM = 8;

__host__ __device__ __forceinline__ int lds_byte(int r, int c) { const int st = (r >> 4) * 2 + (c >> 5), rr = r & 15, cc = c & 31, ob = rr * 64 + cc * 2; return st * 1024 + (ob ^ (((ob >> 9) & 1) << 5)); }
__host__ __device__ __forceinline__ void stage_rc(int b, int& R, int& C) { const int st = b / 1024, sb = b % 1024, swz = sb ^ (((sb >> 9) & 1) << 5); R = (st >> 1) * 16 + swz / 64; C = (st & 1) * 32 + (swz % 64) / 2; }
__host__ __device__ __forceinline__ int perm32(int rho) { const int n = rho >> 4, i = rho & 15; return 8 * (i >> 2) + 4 * n + (i & 3); }

struct Unit { int pm, pn; };
struct Gemm { const bf16_t* A; const bf16_t* Bt; int M, N, K; size_t bstride; };

struct StaticOrder {
    int nM, nN, nwg, G, c;
    __host__ __device__ void init(int M, int N, int G_, int c_) { nM = M / BM; nN = N / BM; nwg = nM * nN; G = G_; c = c_; }
    __host__ __device__ bool next(int i, Unit& u) const {
        const long L = (long)i * G + c; if (L >= nwg) return false;
        int wgid = (int)L; { const int q = nwg / NXCD, r = nwg % NXCD, xcd = wgid % NXCD, off = wgid / NXCD; wgid = (xcd < r ? xcd * (q + 1) : r * (q + 1) + (xcd - r) * q) + off; }
        const int nig = WGM * nN, gid = wgid / nig, fm = gid * WGM, gsz = (nM - fm) < WGM ? (nM - fm) : WGM;
        u.pm = fm + ((wgid % nig) % gsz); u.pn = (wgid % nig) / gsz; return true;
    }
    __device__ __forceinline__ void a_ready(const Unit&) const {}
    __device__ __forceinline__ void done(const Unit&) const {}
};

typedef float f32x2_cv __attribute__((ext_vector_type(2))); typedef __bf16 bf16x2_cv __attribute__((ext_vector_type(2)));
__device__ __forceinline__ unsigned cvt_pk_bf16(float lo, float hi) { f32x2_cv v = {lo, hi}; bf16x2_cv b = __builtin_convertvector(v, bf16x2_cv); return __builtin_bit_cast(unsigned, b); }
typedef float f32x2 __attribute__((ext_vector_type(2)));
template <class Epi, class Sched, bool ALIGN_EPI = false, bool SP2 = false>
__device__ __forceinline__ void gemm_phase(PG8_LAS unsigned char* lds, const Gemm g, const Sched& S, const Epi& E) {
    int tid_ = threadIdx.x; asm volatile("" : "+v"(tid_));
    const int tid = tid_, wid = __builtin_amdgcn_readfirstlane(tid >> 6), lane = tid & 63, wr = wid >> 2, wc = wid & 3, fr = lane & 15, fq = lane >> 4;
    const int K = g.K, nt = K / BK;
    unsigned voffA[2], voffB[2];
#pragma unroll
    for (int i = 0; i < 2; ++i) { int R, C; stage_rc(tid * 16 + i * 8192, R, C); const int Rb = Epi::PERM ? ((R & ~31) + perm32(R & 31)) : R;
        voffA[i] = (unsigned)(R * K + C) * 2u; voffB[i] = (unsigned)(Rb * K + C) * 2u; }
    const size_t kstep = (size_t)(BK * 2);
    const size_t hstep = (size_t)HALF * K * 2;
    const size_t tstep = 2 * hstep;
    const unsigned ldsw = (unsigned)wid * 1024u;
    const int aoff = lds_byte(wr * 64 + fr, fq * 8), boff = lds_byte(wc * 32 + fr, fq * 8);
#define PG8_SA(b, h) (((b) * 2 + (h)) * HTB)
#define PG8_SB(b, h) ((4 + (b) * 2 + (h)) * HTB)
#define PG8_STAGE(bufoff, gbase, voff) do { _Pragma("unroll") for (int _i = 0; _i < 2; ++_i) \
        __builtin_amdgcn_global_load_lds((const unsigned*)((const char*)(gbase) + (voff)[_i]), (PG8_LAS unsigned*)(lds + (bufoff) + ldsw + _i * 8192), 16, 0, 0); } while (0)
#define PG8_LDA(dst, b, h) do { _Pragma("unroll") for (int m = 0; m < 4; ++m) _Pragma("unroll") for (int k = 0; k < 2; ++k) dst[m][k] = *(const PG8_LAS bf16x8*)(lds + PG8_SA(b, h) + aoff + m * 2048 + k * 1024); } while (0)
#define PG8_LDB(dst, b, h) do { _Pragma("unroll") for (int n = 0; n < 2; ++n) _Pragma("unroll") for (int k = 0; k < 2; ++k) dst[n][k] = *(const PG8_LAS bf16x8*)(lds + PG8_SB(b, h) + boff + n * 2048 + k * 1024); } while (0)
#define PG8_MMA(ai, bj, At, Bt) do { __builtin_amdgcn_s_setprio(1); _Pragma("unroll") for (int m = 0; m < 4; ++m) _Pragma("unroll") for (int n = 0; n < 2; ++n) _Pragma("unroll") for (int k = 0; k < 2; ++k) \
        acc[ai][bj][m][n] = __builtin_amdgcn_mfma_f32_16x16x32_bf16(Bt[n][k], At[m][k], acc[ai][bj][m][n], 0, 0, 0); __builtin_amdgcn_s_setprio(0); } while (0)
#define PG8_WAIT_V(n) asm volatile("s_waitcnt vmcnt(" #n ")" ::: "memory")
#define PG8_WAIT_L(n) asm volatile("s_waitcnt lgkmcnt(" #n ")" ::: "memory")
#define PG8_BAR __builtin_amdgcn_s_barrier()
#define PG8_SCHED __builtin_amdgcn_sched_barrier(0)
    Unit cur, nxt; int ui = 0;
    if (!S.next(0, cur)) return;
    f32x4 acc[2][2][4][2];
#pragma unroll
    for (int a = 0; a < 2; ++a)
#pragma unroll
        for (int b = 0; b < 2; ++b)
#pragma unroll
            for (int m = 0; m < 4; ++m)
#pragma unroll
                for (int n = 0; n < 2; ++n) acc[a][b][m][n] = (f32x4){0.f, 0.f, 0.f, 0.f};
    bf16x8 At[4][2], B0[2][2], B1[2][2];
    const char* cA = (const char*)g.A + (size_t)cur.pm * tstep; const char* cB = (const char*)g.Bt + (size_t)cur.pn * tstep + (size_t)(cur.pm >> 5) * g.bstride;
    S.a_ready(cur);
    if constexpr (SP2) {
        PG8_STAGE(PG8_SB(0, 0), cB, voffB); PG8_STAGE(PG8_SB(0, 1), cB + hstep, voffB); PG8_STAGE(PG8_SA(0, 0), cA, voffA); PG8_STAGE(PG8_SA(0, 1), cA + hstep, voffA);
        if (wr == 1) PG8_BAR;
        PG8_WAIT_V(2); PG8_BAR;
        PG8_STAGE(PG8_SB(1, 0), cB + kstep, voffB); PG8_STAGE(PG8_SA(1, 0), cA + kstep, voffA); PG8_STAGE(PG8_SB(1, 1), cB + hstep + kstep, voffB);
        PG8_WAIT_V(6); PG8_BAR;
    } else {
        PG8_STAGE(PG8_SB(0, 0), cB, voffB); PG8_STAGE(PG8_SA(0, 0), cA, voffA); PG8_STAGE(PG8_SB(0, 1), cB + hstep, voffB); PG8_STAGE(PG8_SA(0, 1), cA + hstep, voffA);
        if (wr == 1) PG8_BAR;
        PG8_WAIT_V(4); PG8_BAR;
        PG8_STAGE(PG8_SB(1, 0), cB + kstep, voffB); PG8_STAGE(PG8_SA(1, 0), cA + kstep, voffA); PG8_STAGE(PG8_SB(1, 1), cB + hstep + kstep, voffB);
        PG8_WAIT_V(6); PG8_BAR;
    }
    for (;;) {
        const bool has_next = S.next(ui + 1, nxt);
        const char* nA = has_next ? (const char*)g.A + (size_t)nxt.pm * tstep : cA; const char* nB = has_next ? (const char*)g.Bt + (size_t)nxt.pn * tstep + (size_t)(nxt.pm >> 5) * g.bstride : cB;
        for (int t = 0; t < nt; t += 2) {
            const bool last = (t == nt - 2);
            const char* a1 = cA + (size_t)(t + 1) * kstep;
            const char* a2 = last ? nA : cA + (size_t)(t + 2) * kstep; const char* b2 = last ? nB : cB + (size_t)(t + 2) * kstep;
            const char* a3 = a2 + kstep; const char* b3 = b2 + kstep;
            if (last && has_next) S.a_ready(nxt);
            if constexpr (SP2) {
            PG8_LDB(B0, 0, 0); PG8_LDB(B1, 0, 1); PG8_SCHED; PG8_LDA(At, 0, 0); PG8_STAGE(PG8_SA(1, 1), a1 + hstep, voffA);
            PG8_WAIT_V(8); PG8_WAIT_L(0); PG8_BAR; PG8_MMA(0, 0, At, B0); PG8_MMA(0, 1, At, B1); PG8_BAR; PG8_SCHED;
            PG8_LDA(At, 0, 1); PG8_STAGE(PG8_SB(0, 0), b2, voffB); PG8_STAGE(PG8_SB(0, 1), b2 + hstep, voffB); PG8_STAGE(PG8_SA(0, 0), a2, voffA);
            PG8_WAIT_V(8); PG8_WAIT_L(0); PG8_BAR; PG8_MMA(1, 0, At, B0); PG8_MMA(1, 1, At, B1); PG8_BAR; PG8_SCHED;
            PG8_LDB(B0, 1, 0); PG8_LDB(B1, 1, 1); PG8_SCHED; PG8_LDA(At, 1, 0); PG8_STAGE(PG8_SA(0, 1), a2 + hstep, voffA);
            PG8_WAIT_V(8); PG8_WAIT_L(0); PG8_BAR; PG8_MMA(0, 0, At, B0); PG8_MMA(0, 1, At, B1); PG8_BAR; PG8_SCHED;
            PG8_LDA(At, 1, 1); PG8_STAGE(PG8_SB(1, 0), b3, voffB); PG8_STAGE(PG8_SB(1, 1), b3 + hstep, voffB); PG8_STAGE(PG8_SA(1, 0), a3, voffA);
            PG8_WAIT_V(8); PG8_WAIT_L(0); PG8_BAR; PG8_MMA(1, 0, At, B0); PG8_MMA(1, 1, At, B1); PG8_BAR; PG8_SCHED;
            } else {
            PG8_LDB(B0, 0, 0); PG8_SCHED; PG8_LDA(At, 0, 0); PG8_STAGE(PG8_SA(1, 1), a1 + hstep, voffA);
            PG8_WAIT_L(8); PG8_BAR; PG8_WAIT_L(0); PG8_MMA(0, 0, At, B0); PG8_BAR; PG8_SCHED;
            PG8_LDB(B1, 0, 1); PG8_STAGE(PG8_SB(0, 0), b2, voffB);
            PG8_BAR; PG8_WAIT_L(0); PG8_MMA(0, 1, At, B1); PG8_BAR;
            PG8_LDA(At, 0, 1); PG8_STAGE(PG8_SA(0, 0), a2, voffA);
            PG8_BAR; PG8_WAIT_L(0); PG8_MMA(1, 0, At, B0); PG8_BAR; PG8_SCHED;
            PG8_STAGE(PG8_SB(0, 1), b2 + hstep, voffB);
            PG8_WAIT_V(6); PG8_BAR; PG8_MMA(1, 1, At, B1); PG8_BAR;
            PG8_LDB(B0, 1, 0); PG8_SCHED; PG8_LDA(At, 1, 0); PG8_STAGE(PG8_SA(0, 1), a2 + hstep, voffA);
            PG8_WAIT_L(8); PG8_BAR; PG8_WAIT_L(0); PG8_MMA(0, 0, At, B0); PG8_BAR; PG8_SCHED;
            PG8_LDB(B1, 1, 1); PG8_STAGE(PG8_SB(1, 0), b3, voffB);
            PG8_BAR; PG8_WAIT_L(0); PG8_MMA(0, 1, At, B1); PG8_BAR;
            PG8_LDA(At, 1, 1); PG8_STAGE(PG8_SA(1, 0), a3, voffA);
            PG8_BAR; PG8_WAIT_L(0); PG8_MMA(1, 0, At, B0); PG8_BAR; PG8_SCHED;
            PG8_STAGE(PG8_SB(1, 1), b3 + hstep, voffB);
            PG8_WAIT_V(6); PG8_BAR; PG8_MMA(1, 1, At, B1); PG8_BAR;
            }
        }
        if constexpr (ALIGN_EPI) { if (wr == 0) PG8_BAR; }
        if constexpr (!Epi::AFTER_DRAIN) { E(acc, cur, wr, wc, fr, fq); S.done(cur); }
        if (!has_next) break;
#pragma unroll
        for (int a = 0; a < 2; ++a)
#pragma unroll
            for (int b = 0; b < 2; ++b)
#pragma unroll
                for (int m = 0; m < 4; ++m)
#pragma unroll
                    for (int n = 0; n < 2; ++n) acc[a][b][m][n] = (f32x4){0.f, 0.f, 0.f, 0.f};
        cur = nxt; cA = nA; cB = nB; ++ui;
        if constexpr (ALIGN_EPI) { if (wr == 1) PG8_BAR; }
    }
    PG8_WAIT_V(0);
    if constexpr (!ALIGN_EPI) { if (wr == 0) PG8_BAR; }
    PG8_BAR;
    if constexpr (Epi::AFTER_DRAIN) { E.fused(acc, cur, wr, wc, fr, fq, lds, wid, lane); S.done(cur); }
#undef PG8_SA
#undef PG8_SB
#undef PG8_STAGE
#undef PG8_LDA
#undef PG8_LDB
#undef PG8_MMA
#undef PG8_WAIT_V
#undef PG8_WAIT_L
#undef PG8_BAR
#undef PG8_SCHED
}
}
#define LAS __attribute__((address_space(3)))
using pg8::bf16_t; using pg8::bf16x8; using pg8::f32x4; using pg8::u32x4; using pg8::Unit; using pg8::cvt_pk_bf16;
typedef float f32x16 __attribute__((ext_vector_type(16)));
typedef short s16x4 __attribute__((ext_vector_type(4)));
typedef unsigned u32x2 __attribute__((ext_vector_type(2)));

constexpr int BATCH = 2, SEQ = 8192, DM = 1024, FF = 4096, DEPTH = 4, M = BATCH * SEQ;
constexpr int INW = 2824, NP = 2816;
constexpr int C_QA = 0, C_KA = 256, C_VA = 512, C_QB = 768, C_KB = 1280, C_VB = 1792, C_UC = 2304, C_VC = 2560;
constexpr float EPS = 1e-6f, LOG2E = 1.4426950408889634f, C2 = 0.125f * LOG2E;
constexpr float ZERO_CUT = -150.0f;

constexpr size_t MiB = 1u << 20;
constexpr size_t WS_CTL = 0;
constexpr size_t WS_MOD = 64 * 1024;
constexpr size_t WS_CIN = WS_MOD + 196608;
constexpr size_t WS_C1 = WS_CIN + 90112;
constexpr size_t WS_CF = WS_C1 + 131072;
constexpr size_t WS_WF = WS_CF + 256;
constexpr size_t WS_TOT = WS_WF + 262144;
constexpr size_t WS_CUM = 1 * MiB;
constexpr size_t WS_SS = 2 * MiB;
constexpr size_t WS_XB = 4 * MiB;
constexpr size_t WS_WIN = 36 * MiB;
constexpr size_t WS_W1 = 80 * MiB;
constexpr size_t WS_WOUT = 144 * MiB;
constexpr size_t WS_W2 = 152 * MiB;
constexpr size_t WS_HID = 184 * MiB;
constexpr size_t WS_PROJ = 184 * MiB;
constexpr size_t WS_MIX = 272 * MiB;
constexpr size_t WS_END = 312 * MiB;

constexpr int NTHREADS = 512, NWAVES = 8;
constexpr int LDS_BYTES = 147456;
constexpr int LDS_MISC = 143360;
constexpr int CW_BAR = 8192, CTL_WORDS = CW_BAR + 3456;

struct Params {
    const float *x, *c, *ada_w, *ada_b, *norm1_g, *norm2_g, *w_in, *b_forget, *q_norm_g, *k_norm_g, *sgu_norm_g, *sgu_w, *sgu_b, *w_out, *mlp_w1, *mlp_w2;
    float* out; unsigned char* ws;
};

__device__ __forceinline__ float ex2(float v) { return __builtin_amdgcn_exp2f(v); }
__device__ __forceinline__ float lg2(float v) { return __builtin_amdgcn_logf(v); }
__device__ __forceinline__ float softplus2(float z) { return fmaxf(z, 0.f) + lg2(1.f + ex2(-fabsf(z))); }
__device__ __forceinline__ float gelu_tanh(float v) { const float u = 0.7978845608028654f * (v + 0.044715f * v * v * v); return v * __builtin_amdgcn_rcpf(1.f + ex2(-2.f * LOG2E * u)); }
__device__ __forceinline__ float rstd_row(const float* SS, int row) {
    const float s = (SS[row] + SS[M + row]) + (SS[2 * M + row] + SS[3 * M + row]);
    return __builtin_amdgcn_rsqf(s * (1.f / DM) + EPS);
}
__device__ __forceinline__ float wave_sum(float v) {
#pragma unroll
    for (int o = 1; o < 64; o <<= 1) v += __shfl_xor(v, o);
    return v;
}
__device__ __forceinline__ float wave_max(float v) {
#pragma unroll
    for (int o = 1; o < 64; o <<= 1) v = fmaxf(v, __shfl_xor(v, o));
    return v;
}


struct EpiIn {
    static constexpr bool PERM = true, AFTER_DRAIN = false;
    bf16_t* P; const float* SS; const float* cin; const float* qg; const float* kg; const float* sg;
    __device__ __forceinline__ void operator()(const f32x4 (&acc)[2][2][4][2], const Unit& u, int wr, int wc, int fr, int fq) const {
        const int b = u.pm >> 5, pn = u.pn;
        const int colw = pn * 256 + 64 * wc + 8 * fq;
        int type;
        const float* gain = nullptr;
        if (pn == 0) type = 1; else if (pn <= 2) type = 0; else if (pn <= 4) { type = 2; gain = qg; } else if (pn <= 6) { type = 3; gain = kg; }
        else if (pn <= 8) type = 0; else if (pn == 9) type = 4; else { type = 5; gain = sg + 64 * wc; }
        f32x4 cb[2][2], gv[2][2];
#pragma unroll
        for (int bj = 0; bj < 2; ++bj)
#pragma unroll
            for (int n = 0; n < 2; ++n) {
                cb[bj][n] = *(const f32x4*)(cin + b * NP + colw + 32 * bj + 4 * n);
                gv[bj][n] = gain ? *(const f32x4*)(gain + 32 * bj + 8 * fq + 4 * n) : (f32x4){1.f, 1.f, 1.f, 1.f};
                if (type == 2) gv[bj][n] = gv[bj][n] * C2;
            }
#pragma unroll
        for (int ai = 0; ai < 2; ++ai)
#pragma unroll
            for (int m = 0; m < 4; ++m) {
                const int row = u.pm * 256 + ai * 128 + wr * 64 + m * 16 + fr;
                const float rs = rstd_row(SS, row);
                f32x4 v[2][2]; float ss = 0.f;
#pragma unroll
                for (int bj = 0; bj < 2; ++bj)
#pragma unroll
                    for (int n = 0; n < 2; ++n) {
                        f32x4 t = acc[ai][bj][m][n] * rs + cb[bj][n];
                        if (type >= 4) { t[0] = gelu_tanh(t[0]); t[1] = gelu_tanh(t[1]); t[2] = gelu_tanh(t[2]); t[3] = gelu_tanh(t[3]); }
                        if (type == 1) t = t * C2;
                        v[bj][n] = t; ss += (t[0] * t[0] + t[1] * t[1]) + (t[2] * t[2] + t[3] * t[3]);
                    }
                if (type == 2 || type == 3 || type == 5) {
                    ss += __shfl_xor(ss, 16); ss += __shfl_xor(ss, 32);
                    const float r = __builtin_amdgcn_rsqf(ss * (1.f / 64.f) + EPS);
#pragma unroll
                    for (int bj = 0; bj < 2; ++bj)
#pragma unroll
                        for (int n = 0; n < 2; ++n) v[bj][n] = v[bj][n] * r * gv[bj][n];
                }
                bf16_t* rowp = P + (size_t)row * NP + colw;
#pragma unroll
                for (int bj = 0; bj < 2; ++bj) {
                    u32x4 w; w.x = cvt_pk_bf16(v[bj][0][0], v[bj][0][1]); w.y = cvt_pk_bf16(v[bj][0][2], v[bj][0][3]); w.z = cvt_pk_bf16(v[bj][1][0], v[bj][1][1]); w.w = cvt_pk_bf16(v[bj][1][2], v[bj][1][3]);
                    *(u32x4*)(rowp + 32 * bj) = w;
                }
            }
    }
};

struct EpiUp {
    static constexpr bool PERM = true, AFTER_DRAIN = false;
    bf16_t* H; const float* SS; const float* c1;
    __device__ __forceinline__ void operator()(const f32x4 (&acc)[2][2][4][2], const Unit& u, int wr, int wc, int fr, int fq) const {
        const int b = u.pm >> 5;
        const int colw = u.pn * 256 + 64 * wc + 8 * fq;
        f32x4 cb[2][2];
#pragma unroll
        for (int bj = 0; bj < 2; ++bj)
#pragma unroll
            for (int n = 0; n < 2; ++n) cb[bj][n] = *(const f32x4*)(c1 + b * FF + colw + 32 * bj + 4 * n);
#pragma unroll
        for (int ai = 0; ai < 2; ++ai)
#pragma unroll
            for (int m = 0; m < 4; ++m) {
                const int row = u.pm * 256 + ai * 128 + wr * 64 + m * 16 + fr;
                const float rs = rstd_row(SS, row);
                bf16_t* rowp = H + (size_t)row * FF + colw;
#pragma unroll
                for (int bj = 0; bj < 2; ++bj) {
                    f32x4 a = acc[ai][bj][m][0] * rs + cb[bj][0], c = acc[ai][bj][m][1] * rs + cb[bj][1];
#pragma unroll
                    for (int e = 0; e < 4; ++e) { const float x = fmaxf(a[e], 0.f), y = fmaxf(c[e], 0.f); a[e] = x * x; c[e] = y * y; }
                    u32x4 w; w.x = cvt_pk_bf16(a[0], a[1]); w.y = cvt_pk_bf16(a[2], a[3]); w.z = cvt_pk_bf16(c[0], c[1]); w.w = cvt_pk_bf16(c[2], c[3]);
                    *(u32x4*)(rowp + 32 * bj) = w;
                }
            }
    }
};

struct EpiRes {
    static constexpr bool PERM = true, AFTER_DRAIN = true;
    const float* base; float* out; bf16_t* xb; float* SS; const float* gate;
    __device__ __forceinline__ void fused(f32x4 (&acc)[2][2][4][2], const Unit& u, int wr, int wc, int fr, int fq, LAS unsigned char* lds, int wid, int lane) const {
        const int b = u.pm >> 5;
        const int colw = u.pn * 256 + 64 * wc + 8 * fq;
        LAS float* Pl = (LAS float*)lds;
        f32x4 gt[2][2];
#pragma unroll
        for (int bj = 0; bj < 2; ++bj)
#pragma unroll
            for (int n = 0; n < 2; ++n) gt[bj][n] = *(const f32x4*)(gate + b * 6144 + colw + 32 * bj + 4 * n);
#pragma unroll
        for (int ai = 0; ai < 2; ++ai)
#pragma unroll
            for (int m = 0; m < 4; ++m) {
                const int rl = ai * 128 + wr * 64 + m * 16 + fr; const size_t off = (size_t)(u.pm * 256 + rl) * DM + colw; float ss = 0.f;
#pragma unroll
                for (int bj = 0; bj < 2; ++bj) {
                    const f32x4 x0 = *(const f32x4*)(base + off + 32 * bj), x1 = *(const f32x4*)(base + off + 32 * bj + 4);
                    const f32x4 a = x0 + gt[bj][0] * acc[ai][bj][m][0], c = x1 + gt[bj][1] * acc[ai][bj][m][1];
                    *(f32x4*)(out + off + 32 * bj) = a; *(f32x4*)(out + off + 32 * bj + 4) = c;
                    u32x4 w; w.x = cvt_pk_bf16(a[0], a[1]); w.y = cvt_pk_bf16(a[2], a[3]); w.z = cvt_pk_bf16(c[0], c[1]); w.w = cvt_pk_bf16(c[2], c[3]);
                    *(u32x4*)(xb + off + 32 * bj) = w;
                    ss += ((a[0] * a[0] + a[1] * a[1]) + (a[2] * a[2] + a[3] * a[3])) + ((c[0] * c[0] + c[1] * c[1]) + (c[2] * c[2] + c[3] * c[3]));
                }
                ss += __shfl_xor(ss, 16); ss += __shfl_xor(ss, 32);
                if (fq == 0) Pl[rl * 4 + wc] = ss;
            }
        __syncthreads();
        const int tid = wid * 64 + lane;
        if (tid < 256) { const f32x4 p = *(const LAS f32x4*)(Pl + tid * 4); SS[(size_t)u.pn * M + u.pm * 256 + tid] = (p[0] + p[1]) + (p[2] + p[3]); }
        __syncthreads();
    }
};
typedef unsigned v4u_xb __attribute__((ext_vector_type(4)));
#define XB_TMO      128
#define XB_XCNT(j)  (256  + 64 * (j))
#define XB_XSUB(j)  (1280 + 64 * (j))
#define XB_XGEN(j)  (2304 + 64 * (j))
#define XB_TOP      3328
#define XB_TOPGEN   3392
#define XCD_BAR_WORDS 3456
#define XB_SPIN_CAP (1u << 18)

__device__ __forceinline__ unsigned xb_ld(unsigned* p)              { return __hip_atomic_load(p, __ATOMIC_RELAXED, __HIP_MEMORY_SCOPE_AGENT); }
__device__ __forceinline__ unsigned xb_add(unsigned* p, unsigned v) { return __hip_atomic_fetch_add(p, v, __ATOMIC_RELAXED, __HIP_MEMORY_SCOPE_AGENT); }
__device__ __forceinline__ unsigned xb_xcc_id() { return (unsigned)__builtin_amdgcn_s_getreg((3 << 11) | 20) & 0xFu; }
#define XB_SPIN(cond, bar) do { unsigned _sp = 0; while (cond) { __builtin_amdgcn_s_sleep(1); \
    if ((++_sp & 255u) == 0u) { if (xb_ld(&(bar)[XB_TMO])) break; if (_sp > XB_SPIN_CAP) { atomicAdd(&(bar)[XB_TMO], 1u); break; } } } } while (0)

struct XcdBarrier {
    unsigned* bar; unsigned x;
    volatile LAS unsigned* st;
};

__device__ __forceinline__ XcdBarrier xcd_barrier_post(unsigned* bar, volatile LAS unsigned* st) {
    XcdBarrier b; b.bar = bar; b.x = xb_xcc_id(); b.st = st;
    if (threadIdx.x == 0) (void)xb_add(&bar[XB_XCNT(b.x)], 1u);
    return b;
}
__device__ __forceinline__ void xcd_barrier_complete(unsigned* bar, unsigned x, unsigned& nloc, unsigned& nx) {
    const unsigned G = gridDim.x * gridDim.y * gridDim.z;
    unsigned sum, cnt, mine, sp = 0u;
    for (;;) {
        sum = 0u; cnt = 0u; mine = 0u;
#pragma unroll
        for (unsigned j = 0; j < 16; ++j) { const unsigned c = xb_ld(&bar[XB_XCNT(j)]); sum += c; cnt += (c > 0u) ? 1u : 0u; mine = (j == x) ? c : mine; }
        if (sum == G) break;
        __builtin_amdgcn_s_sleep(1);
        if ((++sp & 255u) == 0u) { if (xb_ld(&bar[XB_TMO])) break; if (sp > XB_SPIN_CAP) { atomicAdd(&bar[XB_TMO], 1u); break; } }
    }
    nloc = mine > 0u ? mine : 1u; nx = cnt > 0u ? cnt : 1u;
}

__device__ __forceinline__ void xcd_barrier(const XcdBarrier& b) {
    asm volatile("s_waitcnt vmcnt(0)" ::: "memory");
    __syncthreads();
    if (threadIdx.x == 0) {
        unsigned* bar = b.bar;
        __builtin_amdgcn_s_waitcnt(0);
        unsigned nloc = b.st[0], nx = b.st[1];
        if (nloc == 0u) { xcd_barrier_complete(bar, b.x, nloc, nx); b.st[0] = nloc; b.st[1] = nx; }
        const unsigned old = xb_add(&bar[XB_XSUB(b.x)], 1u);
        const unsigned gen = old / nloc;
        if (old + 1u == (gen + 1u) * nloc) {
            __builtin_amdgcn_fence(__ATOMIC_RELEASE, "agent");
            asm volatile("s_waitcnt vmcnt(0)" ::: "memory");
            const unsigned og = xb_add(&bar[XB_TOP], 1u);
            const unsigned tg = og / nx;
            if (og + 1u == (tg + 1u) * nx) xb_add(&bar[XB_TOPGEN], 1u);
            else XB_SPIN(xb_ld(&bar[XB_TOPGEN]) == tg, bar);
            __builtin_amdgcn_fence(__ATOMIC_ACQUIRE, "agent");
            xb_add(&bar[XB_XGEN(b.x)], 1u);
            asm volatile("s_waitcnt vmcnt(0)" ::: "memory");
        } else {
            XB_SPIN(xb_ld(&bar[XB_XGEN(b.x)]) == gen, bar);
            __builtin_amdgcn_fence(__ATOMIC_ACQUIRE, "agent");
            asm volatile("s_waitcnt vmcnt(0)" ::: "memory");
        }
    }
    __syncthreads();
}
#ifndef FOX_CUT
#define FOX_CUT ZERO_CUT
#endif
constexpr int KCH = 1040, WL_K = 0, WL_V = 8320, VDH = 4160, WL_WSF = 16640, WL_CUM = 16896, WL_BYTES = 17152;
__device__ __forceinline__ int crow(int r, int hi) { return (r & 3) + 8 * (r >> 2) + 4 * hi; }
__device__ __forceinline__ f32x16 mfma32(bf16x8 a, bf16x8 b, f32x16 c) { return __builtin_amdgcn_mfma_f32_32x32x16_bf16(a, b, c, 0, 0, 0); }
__device__ __forceinline__ s16x4 vtr(const LAS unsigned char* p) { return __builtin_bit_cast(s16x4, __builtin_amdgcn_ds_read_tr16_b64_v4i16((LAS s16x4*)p)); }
__device__ __forceinline__ float swap_sum(float v, float& partner, int hi) {
    auto rr = __builtin_amdgcn_permlane32_swap(__float_as_uint(v), __float_as_uint(v), false, false);
    const float a = __uint_as_float(rr[0]), b = __uint_as_float(rr[1]); partner = hi ? a : b; return a + b;
}
__device__ __forceinline__ float swap_max(float v) {
    auto rr = __builtin_amdgcn_permlane32_swap(__float_as_uint(v), __float_as_uint(v), false, false);
    return fmaxf(__uint_as_float(rr[0]), __uint_as_float(rr[1]));
}

struct TileRegs { u32x4 kv[8], vv[8]; };
template <bool WITH_K>
__device__ __forceinline__ void issue_tile(TileRegs& R, const bf16_t* Kg, const bf16_t* Vg, int lane) {
    const int k8 = lane >> 3, ch = lane & 7;
#pragma unroll
    for (int i = 0; i < 8; ++i) { const int key = k8 + 8 * i;
        if (WITH_K) R.kv[i] = *(const u32x4*)(Kg + (size_t)key * NP + ch * 8);
        R.vv[i] = *(const u32x4*)(Vg + (size_t)key * NP + ch * 8); }
}
template <bool WITH_K>
__device__ __forceinline__ void store_tile(LAS unsigned char* wl, const TileRegs& R, int lane) {
    const int k8 = lane >> 3, ch = lane & 7;
#pragma unroll
    for (int i = 0; i < 8; ++i) { const int key = k8 + 8 * i;
        if (WITH_K) *(LAS u32x4*)(wl + WL_K + ch * KCH + key * 16) = R.kv[i];
        *(LAS u32x4*)(wl + WL_V + (ch >> 2) * VDH + (key >> 4) * 1024 + (key & 15) * 64 + (ch & 3) * 16) = R.vv[i]; }
}
template <bool WITH_K>
__device__ __forceinline__ void load_tile(LAS unsigned char* wl, const bf16_t* Kg, const bf16_t* Vg, int lane) { TileRegs R; issue_tile<WITH_K>(R, Kg, Vg, lane); store_tile<WITH_K>(wl, R, lane); }
__device__ __forceinline__ void qk(f32x16& p0, f32x16& p1, const LAS unsigned char* wl, const bf16x8* qr, int r32, int hi) {
    const LAS unsigned char* kp = wl + WL_K + hi * KCH + r32 * 16;
#pragma unroll
    for (int d0 = 0; d0 < 4; ++d0) {
        const bf16x8 a0 = *(const LAS bf16x8*)(kp + d0 * 2 * KCH), a1 = *(const LAS bf16x8*)(kp + d0 * 2 * KCH + 512);
        p0 = mfma32(a0, qr[d0], p0); p1 = mfma32(a1, qr[d0], p1);
        if (d0 & 1) __builtin_amdgcn_sched_barrier(0);
    }
}
__device__ __forceinline__ void pack_p(u32x4* pw, const f32x16& p0, const f32x16& p1) {
    pw[0] = (u32x4){cvt_pk_bf16(p0[0], p0[1]), cvt_pk_bf16(p0[2], p0[3]), cvt_pk_bf16(p0[4], p0[5]), cvt_pk_bf16(p0[6], p0[7])};
    pw[1] = (u32x4){cvt_pk_bf16(p0[8], p0[9]), cvt_pk_bf16(p0[10], p0[11]), cvt_pk_bf16(p0[12], p0[13]), cvt_pk_bf16(p0[14], p0[15])};
    pw[2] = (u32x4){cvt_pk_bf16(p1[0], p1[1]), cvt_pk_bf16(p1[2], p1[3]), cvt_pk_bf16(p1[4], p1[5]), cvt_pk_bf16(p1[6], p1[7])};
    pw[3] = (u32x4){cvt_pk_bf16(p1[8], p1[9]), cvt_pk_bf16(p1[10], p1[11]), cvt_pk_bf16(p1[12], p1[13]), cvt_pk_bf16(p1[14], p1[15])};
}
__device__ __forceinline__ void pv(f32x16* o, const LAS unsigned char* wl, int lane, int hi, const u32x4* pw) {
    const LAS unsigned char* vp = wl + WL_V + ((lane >> 4) & 1) * 32 + (lane & 3) * 8 + (4 * hi + ((lane & 15) >> 2)) * 64;
#pragma unroll
    for (int d0 = 0; d0 < 2; ++d0)
#pragma unroll
        for (int ks = 0; ks < 4; ++ks) {
            const s16x4 lo = vtr(vp + d0 * VDH + ks * 1024), hh = vtr(vp + d0 * VDH + ks * 1024 + 512);
            const bf16x8 vf = (bf16x8){lo[0], lo[1], lo[2], lo[3], hh[0], hh[1], hh[2], hh[3]};
            o[d0] = mfma32(__builtin_bit_cast(bf16x8, pw[ks]), vf, o[d0]);
            if (ks & 1) __builtin_amdgcn_sched_barrier(0);
        }
}
__device__ __forceinline__ void emit_o(const f32x16* o, LAS unsigned char* wl, int lane, int r32, int hi, bf16_t* dst  , const bf16_t* gate  ) {
    LAS float* stg = (LAS float*)(wl + WL_K);
#pragma unroll
    for (int r = 0; r < 16; ++r) { const int orow = crow(r, hi);
#pragma unroll
        for (int d0 = 0; d0 < 2; ++d0) stg[orow * 64 + d0 * 32 + r32] = o[d0][r]; }
#pragma unroll
    for (int i = 0; i < 4; ++i) { const int row = i * 8 + (lane >> 3), ch = lane & 7;
        f32x4 a = *(const LAS f32x4*)(stg + row * 64 + ch * 8), c = *(const LAS f32x4*)(stg + row * 64 + ch * 8 + 4);
        if (gate) { const u32x4 g = *(const u32x4*)(gate + (size_t)row * NP + ch * 8);
            a[0] *= __uint_as_float(g.x << 16); a[1] *= __uint_as_float(g.x & 0xffff0000u); a[2] *= __uint_as_float(g.y << 16); a[3] *= __uint_as_float(g.y & 0xffff0000u);
            c[0] *= __uint_as_float(g.z << 16); c[1] *= __uint_as_float(g.z & 0xffff0000u); c[2] *= __uint_as_float(g.w << 16); c[3] *= __uint_as_float(g.w & 0xffff0000u); }
        u32x4 w; w.x = cvt_pk_bf16(a[0], a[1]); w.y = cvt_pk_bf16(a[2], a[3]); w.z = cvt_pk_bf16(c[0], c[1]); w.w = cvt_pk_bf16(c[2], c[3]);
        *(u32x4*)(dst + (size_t)row * DM + ch * 8) = w; }
}

__device__ __forceinline__ void fox_item(LAS unsigned char* wl, int lane, const bf16_t* PROJ, bf16_t* MIX, const float* CUM, const float* TOT, float zmax2, int bh, int qblk) {
    const int r32 = lane & 31, hi = lane >> 5, b = bh >> 3, h = bh & 7, t0 = qblk * 32;
    const size_t rowb = (size_t)b * SEQ;
    const bf16_t* Qg = PROJ + (rowb + t0 + r32) * NP + C_QB + h * 64;
    bf16x8 qr[4];
#pragma unroll
    for (int d0 = 0; d0 < 4; ++d0) qr[d0] = *(const bf16x8*)(Qg + 16 * d0 + 8 * hi);
    const float* cum = CUM + (size_t)bh * SEQ; const float* tot = TOT + bh * 32;
    const float cq = cum[t0 + r32];
    LAS float* wsf = (LAS float*)(wl + WL_WSF);
    LAS float* wcum = (LAS float*)(wl + WL_CUM);
    float m = 0.f, l = 0.f, Doff = 0.f; f32x16 o[2]; o[0] = f32x16{}; o[1] = f32x16{};
    const bf16_t* Kb = PROJ + rowb * NP + C_KB + h * 64; const bf16_t* Vb = PROJ + rowb * NP + C_VB + h * 64;
    int s0 = t0 & ~63, ucur = t0 >> 8; bool first = true;
    TileRegs R; float cl, tn = 0.f; int un = ucur;
    issue_tile<true>(R, Kb + (size_t)s0 * NP, Vb + (size_t)s0 * NP, lane); cl = cum[s0 + lane];
    for (;;) {
        Doff += tn; ucur = un;
        if (!first) { const float c_last = __builtin_amdgcn_readlane(cl, 63); if (__all(zmax2 + cq - c_last + Doff - m < FOX_CUT)) break; }
        store_tile<true>(wl, R, lane); wcum[lane] = cl;
        if (s0 >= 64) { const int s1 = s0 - 64; issue_tile<true>(R, Kb + (size_t)s1 * NP, Vb + (size_t)s1 * NP, lane); cl = cum[s1 + lane]; un = s1 >> 8; tn = (un != ucur) ? tot[un] : 0.f;
 }
        __builtin_amdgcn_sched_barrier(0);
        f32x16 p0, p1; const float cb = cq + Doff - m;
#pragma unroll
        for (int j = 0; j < 4; ++j) { const f32x4 c0 = *(const LAS f32x4*)(wcum + 8 * j + 4 * hi), c1 = *(const LAS f32x4*)(wcum + 32 + 8 * j + 4 * hi);
#pragma unroll
            for (int e = 0; e < 4; ++e) { p0[4 * j + e] = cb - c0[e]; p1[4 * j + e] = cb - c1[e]; } }
        qk(p0, p1, wl, qr, r32, hi);
        if (first) { const int t = t0 + r32;
#pragma unroll
            for (int r = 0; r < 16; ++r) { const int key = s0 + crow(r, hi); if (key > t) p0[r] = -INFINITY; if (key + 32 > t) p1[r] = -INFINITY; } }
        float rm = fmaxf(p0[0], p1[0]);
#pragma unroll
        for (int r = 1; r < 16; ++r) rm = fmaxf(rm, fmaxf(p0[r], p1[r]));
        rm = swap_max(rm);
        if (first || __any(rm > 0.f)) {
            const float dl = first ? rm : fmaxf(rm, 0.f); m += dl;
            const float sc = ex2(-dl); l *= sc; if (hi == 0) wsf[r32] = sc;
#pragma unroll
            for (int r = 0; r < 16; ++r) { p0[r] -= dl; p1[r] -= dl; }
            if (!first) {
#pragma unroll
                for (int r = 0; r < 16; ++r) { const float f = wsf[crow(r, hi)]; o[0][r] *= f; o[1][r] *= f; } }
        }
        float ls = 0.f;
#pragma unroll
        for (int r = 0; r < 16; ++r) { p0[r] = ex2(p0[r]); p1[r] = ex2(p1[r]); ls += p0[r] + p1[r]; }
        l += ls;
        u32x4 pw[4]; pack_p(pw, p0, p1);
        pv(o, wl, lane, hi, pw);
        if (s0 == 0) break;
        s0 -= 64; first = false;
    }
    float dummy; l = swap_sum(l, dummy, hi);
    if (hi == 0) wsf[32 + r32] = __builtin_amdgcn_rcpf(l);
#pragma unroll
    for (int r = 0; r < 16; ++r) { const float f = wsf[32 + crow(r, hi)]; o[0][r] *= f; o[1][r] *= f; }
    emit_o(o, wl, lane, r32, hi, MIX + (rowb + t0) * DM + 256 + h * 64, nullptr);
}

__device__ __forceinline__ void sb_item(LAS unsigned char* wl, int lane, const bf16_t* PROJ, bf16_t* MIX, int bh, int qblk) {
    const int r32 = lane & 31, hi = lane >> 5, b = bh >> 2, h = bh & 3, t0 = qblk * 32;
    const size_t rowb = (size_t)b * SEQ;
    const bf16_t* Qg = PROJ + (rowb + t0 + r32) * NP + C_QA + h * 64;
    bf16x8 qr[4];
#pragma unroll
    for (int d0 = 0; d0 < 4; ++d0) qr[d0] = *(const bf16x8*)(Qg + 16 * d0 + 8 * hi);
    float R = 0.f; f32x16 o[2]; o[0] = f32x16{}; o[1] = f32x16{};
    const bf16_t* Kb = PROJ + rowb * NP + C_KA + h * 64; const bf16_t* Vb = PROJ + rowb * NP + C_VA + h * 64;
    int s0 = t0 & ~63; bool first = true;
    for (;;) {
        if (!first && __all(R < ZERO_CUT)) break;
        load_tile<true>(wl, Kb + (size_t)s0 * NP, Vb + (size_t)s0 * NP, lane);
        f32x16 p0 = f32x16{}, p1 = f32x16{};
        qk(p0, p1, wl, qr, r32, hi);
        f32x16 L0, L1; const int t = t0 + r32;
#pragma unroll
        for (int r = 0; r < 16; ++r) {
            const float s0p = softplus2(p0[r]), s1p = softplus2(p1[r]);
            L0[r] = -s0p; L1[r] = -s1p; p0[r] -= s0p; p1[r] -= s1p;
            if (first) { const int key = s0 + crow(r, hi); if (key >= t) { L0[r] = 0.f; p0[r] = -INFINITY; } if (key + 32 >= t) { L1[r] = 0.f; p1[r] = -INFINITY; } }
        }
        float T[8], PG[8];
#pragma unroll
        for (int j = 0; j < 4; ++j) {
            const float g0 = (L0[4 * j] + L0[4 * j + 1]) + (L0[4 * j + 2] + L0[4 * j + 3]), g1 = (L1[4 * j] + L1[4 * j + 1]) + (L1[4 * j + 2] + L1[4 * j + 3]);
            T[j] = swap_sum(g0, PG[j], hi); T[4 + j] = swap_sum(g1, PG[4 + j], hi);
        }
        float acc = 0.f, Suf[8];
#pragma unroll
        for (int j = 7; j >= 0; --j) { Suf[j] = acc + (hi == 0 ? PG[j] : 0.f); acc += T[j]; }
#pragma unroll
        for (int j = 0; j < 4; ++j) {
            { const float b3 = R + Suf[j], b2 = b3 + L0[4 * j + 3], b1 = b2 + L0[4 * j + 2], b0 = b1 + L0[4 * j + 1];
              p0[4 * j] = ex2(p0[4 * j] + b0); p0[4 * j + 1] = ex2(p0[4 * j + 1] + b1); p0[4 * j + 2] = ex2(p0[4 * j + 2] + b2); p0[4 * j + 3] = ex2(p0[4 * j + 3] + b3); }
            { const float b3 = R + Suf[4 + j], b2 = b3 + L1[4 * j + 3], b1 = b2 + L1[4 * j + 2], b0 = b1 + L1[4 * j + 1];
              p1[4 * j] = ex2(p1[4 * j] + b0); p1[4 * j + 1] = ex2(p1[4 * j + 1] + b1); p1[4 * j + 2] = ex2(p1[4 * j + 2] + b2); p1[4 * j + 3] = ex2(p1[4 * j + 3] + b3); }
        }
        R += acc;
        u32x4 pw[4]; pack_p(pw, p0, p1);
        pv(o, wl, lane, hi, pw);
        if (s0 == 0) break;
        s0 -= 64; first = false;
    }
    emit_o(o, wl, lane, r32, hi, MIX + (rowb + t0) * DM + h * 64, nullptr);
}

__device__ __forceinline__ void sgu_item(LAS unsigned char* wl, int lane, const bf16_t* PROJ, bf16_t* MIX, const float* sw  , const float* sbias  , int b, int chunk, int g, int tq) {
    const int r32 = lane & 31, hi = lane >> 5;
    const size_t row0 = (size_t)b * SEQ + chunk * 128;
    const int t = tq * 32 + r32;
    const float* wrow = sw + ((size_t)g * 128 + t) * 128;
    f32x16 o[2]; o[0] = f32x16{}; o[1] = f32x16{};
    for (int kt = 0; kt <= (tq >> 1); ++kt) {
        load_tile<false>(wl, nullptr, PROJ + (row0 + kt * 64) * NP + C_VC + g * 64, lane);
        u32x4 pw[4];
#pragma unroll
        for (int ks = 0; ks < 4; ++ks) { const int kb = kt * 64 + ks * 16 + 4 * hi;
            f32x4 a = *(const f32x4*)(wrow + kb), c = *(const f32x4*)(wrow + kb + 8);
#pragma unroll
            for (int e = 0; e < 4; ++e) { if (kb + e > t) a[e] = 0.f; if (kb + 8 + e > t) c[e] = 0.f; }
            pw[ks] = (u32x4){cvt_pk_bf16(a[0], a[1]), cvt_pk_bf16(a[2], a[3]), cvt_pk_bf16(c[0], c[1]), cvt_pk_bf16(c[2], c[3])}; }
        pv(o, wl, lane, hi, pw);
    }
#pragma unroll
    for (int r = 0; r < 16; ++r) { const float bb = sbias[g * 128 + tq * 32 + crow(r, hi)]; o[0][r] += bb; o[1][r] += bb; }
    emit_o(o, wl, lane, r32, hi, MIX + (row0 + tq * 32) * DM + 768 + g * 64, PROJ + (row0 + tq * 32) * NP + C_UC + g * 64);
}

__device__ __forceinline__ void mixers_phase(const Params& p, int l, LAS unsigned char* lds, int tid) {
    const int lane = tid & 63, wid = __builtin_amdgcn_readfirstlane(tid >> 6);
    LAS unsigned char* wl = lds + wid * WL_BYTES;
    const bf16_t* PROJ = (const bf16_t*)(p.ws + WS_PROJ); bf16_t* MIX = (bf16_t*)(p.ws + WS_MIX);
    const float* CUM = (const float*)(p.ws + WS_CUM); const float* TOT = (const float*)(p.ws + WS_TOT);
    const float gq = wave_max(fabsf(p.q_norm_g[l * 64 + lane])), gk = wave_max(fabsf(p.k_norm_g[l * 64 + lane]));
    const float zmax2 = 64.f * C2 * gq * gk * 1.02f;
    unsigned horder = 0;
    { float bfv[8];
#pragma unroll
      for (int h = 0; h < 8; ++h) bfv[h] = p.b_forget[l * 8 + h];
#pragma unroll
      for (int h = 0; h < 8; ++h) { int rank = 0;
#pragma unroll
          for (int g = 0; g < 8; ++g) rank += (bfv[g] > bfv[h] || (bfv[g] == bfv[h] && g < h)) ? 1 : 0;
          horder |= (unsigned)h << (4 * rank); } }
    const unsigned x0 = xb_xcc_id() & 7u;
#pragma unroll 1
    for (unsigned k = 0; k < 8u; ++k) {
        const unsigned q = (x0 + k) & 7u; unsigned* ctr = (unsigned*)(p.ws + WS_CTL) + (l * 8 + (int)q) * 64;
        if (k) { unsigned seen = 0; if (lane == 0) seen = __hip_atomic_load(ctr, __ATOMIC_RELAXED, __HIP_MEMORY_SCOPE_AGENT); if ((unsigned)__builtin_amdgcn_readfirstlane(seen) >= 1024u) continue; }
        unsigned j = 0; if (lane == 0) j = __hip_atomic_fetch_add(ctr, 1u, __ATOMIC_RELAXED, __HIP_MEMORY_SCOPE_AGENT);
        j = __builtin_amdgcn_readfirstlane(j);
        while (j < 1024u) {
            unsigned jn = 0; if (lane == 0) jn = __hip_atomic_fetch_add(ctr, 1u, __ATOMIC_RELAXED, __HIP_MEMORY_SCOPE_AGENT);
            if (j < 512u) { const unsigned slot = j >> 5, hh = (horder >> (4u * (slot >> 1))) & 7u; fox_item(wl, lane, PROJ, MIX, CUM, TOT, zmax2, (int)((slot & 1u) * 8u + hh), (int)(32u * q + 31u - (j & 31u))); }
            else if (j < 768u) { const unsigned jj = j - 512u; sb_item(wl, lane, PROJ, MIX, (int)(jj >> 5), (int)(32u * q + 31u - (jj & 31u))); }
            else { const unsigned jj = j - 768u, bc = 16u * q + (jj >> 4); sgu_item(wl, lane, PROJ, MIX, p.sgu_w + (size_t)l * 4 * 128 * 128, p.sgu_b + (size_t)l * 4 * 128, (int)(bc >> 6), (int)(bc & 63u), (int)((jj >> 2) & 3u), 3 - (int)(jj & 3u)); }
            j = __builtin_amdgcn_readfirstlane(jn);
        }
    }
}
__device__ __forceinline__ int bt_row(int a) { return (a & ~255) + 128 * ((a >> 5) & 1) + 32 * ((a >> 6) & 3) + (a & 31); }

__device__ __forceinline__ void gemv2_item(const float* W, int ldw, int N, int n0, const float* vec, int vstride, bool do_silu, const float* bias, float* out, int ostride, int mode, float* cf_out, LAS float* red, int tid) {
    const int cgp = tid & 15, kg = tid >> 4, n = n0 + 4 * cgp;
    f32x4 a0 = {0.f, 0.f, 0.f, 0.f}, a1 = {0.f, 0.f, 0.f, 0.f};
    if (n < N) {
#pragma unroll 8
        for (int i = 0; i < 32; ++i) { const int k = kg * 32 + i;
            float v0 = vec[k], v1 = vec[vstride + k];
            if (do_silu) { v0 = v0 * __builtin_amdgcn_rcpf(1.f + ex2(-LOG2E * v0)); v1 = v1 * __builtin_amdgcn_rcpf(1.f + ex2(-LOG2E * v1)); }
            const f32x4 w = *(const f32x4*)(W + (size_t)k * ldw + n);
            a0 += w * v0; a1 += w * v1; }
    }
    *(LAS f32x4*)(red + (kg * 2 + 0) * 64 + 4 * cgp) = a0; *(LAS f32x4*)(red + (kg * 2 + 1) * 64 + 4 * cgp) = a1;
    __syncthreads();
    if (tid < 128) { const int b = tid >> 6, c = tid & 63, nn = n0 + c;
        if (nn < N) { float s = 0.f;
#pragma unroll 8
            for (int g = 0; g < 32; ++g) s += red[(g * 2 + b) * 64 + c];
            if (bias) s += bias[nn];
            if (mode == 0) out[b * ostride + nn] = s;
            else { if (nn < 2304) out[b * ostride + nn] = s; else if (nn < 2312) cf_out[b * 8 + nn - 2304] = s; else out[b * ostride + nn - 8] = s; } } }
    __syncthreads();
}

__device__ __forceinline__ void transpose_item(const float* W, int ldw, int K, int k0, int ncol0  , bf16_t* Bt0, bf16_t* Bt1  , int drow0  ,
                                               const LAS float* als  , LAS float* scr, int lane) {
    float tv[32];
#pragma unroll
    for (int i = 0; i < 32; ++i) { const int kk = 2 * i + (lane >> 5); tv[i] = W[(size_t)(k0 + kk) * ldw + ncol0 + (lane & 31)]; }
#pragma unroll
    for (int i = 0; i < 32; ++i) { const int kk = 2 * i + (lane >> 5); scr[kk * 33 + (lane & 31)] = tv[i]; }
    const int c = lane & 7;
    float s0[8], s1[8];
#pragma unroll
    for (int e = 0; e < 8; ++e) { s0[e] = als ? als[8 * c + e] : 1.f; s1[e] = als ? als[64 + 8 * c + e] : 1.f; }
#pragma unroll
    for (int j = 0; j < 4; ++j) { const int n = (lane >> 3) + 8 * j; const LAS float* s = scr + (8 * c) * 33 + n;
        float v[8];
#pragma unroll
        for (int e = 0; e < 8; ++e) v[e] = s[e * 33];
        u32x4 o; o.x = cvt_pk_bf16(v[0] * s0[0], v[1] * s0[1]); o.y = cvt_pk_bf16(v[2] * s0[2], v[3] * s0[3]); o.z = cvt_pk_bf16(v[4] * s0[4], v[5] * s0[5]); o.w = cvt_pk_bf16(v[6] * s0[6], v[7] * s0[7]);
        *(u32x4*)(Bt0 + (size_t)(drow0 + n) * K + k0 + 8 * c) = o;
        if (Bt1) { u32x4 q; q.x = cvt_pk_bf16(v[0] * s1[0], v[1] * s1[1]); q.y = cvt_pk_bf16(v[2] * s1[2], v[3] * s1[3]); q.z = cvt_pk_bf16(v[4] * s1[4], v[5] * s1[5]); q.w = cvt_pk_bf16(v[6] * s1[6], v[7] * s1[7]);
            *(u32x4*)(Bt1 + (size_t)(drow0 + n) * K + k0 + 8 * c) = q; } }
}

__device__ __forceinline__ void p0_phase(const Params& p, LAS unsigned char* lds, int tid) {
    const int lane = tid & 63, wid = __builtin_amdgcn_readfirstlane(tid >> 6);
    float* MOD = (float*)(p.ws + WS_MOD);
    for (int it = blockIdx.x; it < DEPTH * 96; it += gridDim.x) { const int l = it / 96, nb = it % 96;
        gemv2_item(p.ada_w + (size_t)l * DM * 6144, 6144, 6144, nb * 64, p.c, DM, true, p.ada_b + l * 6144, MOD + (size_t)l * 2 * 6144, 6144, 0, nullptr, (LAS float*)lds, tid); }
    LAS float* scr = (LAS float*)(lds + wid * 16384);
    const int gw = blockIdx.x * NWAVES + wid, NGW = gridDim.x * NWAVES;
    bf16_t* WOUT = (bf16_t*)(p.ws + WS_WOUT); bf16_t* W2 = (bf16_t*)(p.ws + WS_W2);
    constexpr int I_O = (DM / 64) * (DM / 32), I_2 = (FF / 64) * (DM / 32), I_L = I_O + I_2;
    for (int it = gw; it < DEPTH * I_L; it += NGW) { const int l = it / I_L; int r = it % I_L;
        if (r < I_O) { const int kb = r / 32, nb = r % 32; transpose_item(p.w_out + (size_t)l * DM * DM, DM, DM, kb * 64, nb * 32, WOUT + (size_t)l * DM * DM, nullptr, bt_row(nb * 32), nullptr, scr, lane); }
        else { r -= I_O; const int kb = r / 32, nb = r % 32; transpose_item(p.mlp_w2 + (size_t)l * FF * DM, DM, FF, kb * 64, nb * 32, W2 + (size_t)l * DM * FF, nullptr, bt_row(nb * 32), nullptr, scr, lane); } }
    bf16_t* XB = (bf16_t*)(p.ws + WS_XB); float* SS = (float*)(p.ws + WS_SS);
    for (int row = gw; row < M; row += NGW) {
        const f32x4* xr = (const f32x4*)(p.x + (size_t)row * DM) + lane; float s = 0.f; f32x4 v[4];
#pragma unroll
        for (int j = 0; j < 4; ++j) { v[j] = xr[64 * j]; s += (v[j][0] * v[j][0] + v[j][1] * v[j][1]) + (v[j][2] * v[j][2] + v[j][3] * v[j][3]); }
        s = wave_sum(s);
        u32x2* o8 = (u32x2*)(XB + (size_t)row * DM) + lane;
#pragma unroll
        for (int j = 0; j < 4; ++j) o8[64 * j] = (u32x2){cvt_pk_bf16(v[j][0], v[j][1]), cvt_pk_bf16(v[j][2], v[j][3])};
        if (lane < 4) SS[(size_t)lane * M + row] = lane == 0 ? s : 0.f;
    }
}

__device__ __forceinline__ void p1_phase(const Params& p, LAS unsigned char* lds, int tid) {
    const int lane = tid & 63, wid = __builtin_amdgcn_readfirstlane(tid >> 6);
    const float* MOD = (const float*)(p.ws + WS_MOD);
    float* CIN = (float*)(p.ws + WS_CIN); float* C1 = (float*)(p.ws + WS_C1); float* CF = (float*)(p.ws + WS_CF); float* WF = (float*)(p.ws + WS_WF);
    for (int it = blockIdx.x; it < DEPTH * (45 + 64); it += gridDim.x) { const int l = it / 109, r = it % 109;
        if (r < 45) gemv2_item(p.w_in + (size_t)l * DM * INW, INW, INW, r * 64, MOD + (size_t)l * 2 * 6144, 6144, false, nullptr, CIN + (size_t)l * 2 * NP, NP, 1, CF + l * 16, (LAS float*)lds, tid);
        else gemv2_item(p.mlp_w1 + (size_t)l * DM * FF, FF, FF, (r - 45) * 64, MOD + (size_t)l * 2 * 6144 + 3072, 6144, false, nullptr, C1 + (size_t)l * 2 * FF, FF, 0, nullptr, (LAS float*)lds, tid); }
    for (int i = blockIdx.x * NTHREADS + tid; i < DEPTH * 2 * 8 * DM; i += gridDim.x * NTHREADS) {
        const int k = i & 1023, h = (i >> 10) & 7, b = (i >> 13) & 1, l = i >> 14;
        const float al = p.norm1_g[l * DM + k] * (1.f + MOD[((size_t)l * 2 + b) * 6144 + 1024 + k]);
        { const float wv = al * p.w_in[((size_t)l * DM + k) * INW + 2304 + h]; const float nb = __shfl_down(wv, 1); if (!(k & 1)) ((unsigned*)WF)[i >> 1] = cvt_pk_bf16(wv, nb); }
    }
    __syncthreads();
    LAS float* scr = (LAS float*)(lds + wid * 16384);
    LAS float* als = scr + 64 * 33;
    const int gw = blockIdx.x * NWAVES + wid, NGW = gridDim.x * NWAVES;
    bf16_t* WIN = (bf16_t*)(p.ws + WS_WIN); bf16_t* W1 = (bf16_t*)(p.ws + WS_W1);
    constexpr int I_I = (DM / 64) * (NP / 32), I_1 = (DM / 64) * (FF / 32), I_L = I_I + I_1;
    for (int it = gw; it < DEPTH * I_L; it += NGW) { const int l = it / I_L; int r = it % I_L;
        const bool isin = r < I_I; if (!isin) r -= I_I;
        const int nblk = isin ? NP / 32 : FF / 32, kb = r / nblk, nb = r % nblk, k0 = kb * 64;
        { const float g = isin ? p.norm1_g[l * DM + k0 + lane] : p.norm2_g[l * DM + k0 + lane]; const int so = isin ? 1024 : 4096;
          als[lane] = g * (1.f + MOD[((size_t)l * 2 + 0) * 6144 + so + k0 + lane]); als[64 + lane] = g * (1.f + MOD[((size_t)l * 2 + 1) * 6144 + so + k0 + lane]); }
        if (isin) { const int cc = nb * 32, src = cc < 2304 ? cc : cc + 8;
            transpose_item(p.w_in + (size_t)l * DM * INW, INW, DM, k0, src, WIN + ((size_t)l * 2 + 0) * NP * DM, WIN + ((size_t)l * 2 + 1) * NP * DM, bt_row(cc), als, scr, lane); }
        else transpose_item(p.mlp_w1 + (size_t)l * DM * FF, FF, DM, k0, nb * 32, W1 + ((size_t)l * 2 + 0) * FF * DM, W1 + ((size_t)l * 2 + 1) * FF * DM, bt_row(nb * 32), als, scr, lane);
    }
}
__device__ __forceinline__ void fl_unit(const Params& p, int l, int unit, LAS unsigned char* lds, int tid) {
    const int lane = tid & 63, wid = __builtin_amdgcn_readfirstlane(tid >> 6), r32 = lane & 31, hi = lane >> 5;
    const int b = unit >> 5, row0 = unit * 256;
    const bf16_t* XB = (const bf16_t*)(p.ws + WS_XB); const float* SS = (const float*)(p.ws + WS_SS);
    const bf16_t* WFB = (const bf16_t*)(p.ws + WS_WF) + ((size_t)l * 2 + b) * 8 * DM; const float* CF = (const float*)(p.ws + WS_CF) + l * 16 + b * 8;
    float* CUM = (float*)(p.ws + WS_CUM); float* TOT = (float*)(p.ws + WS_TOT);
    LAS float* accs = (LAS float*)lds;
    LAS float* lf = accs + 2048;
    {
        const bf16_t* xrow = XB + (size_t)(row0 + wid * 32 + r32) * DM + 8 * hi;
        const bf16_t* wrow = WFB + (size_t)(r32 & 7) * DM + 8 * hi;
        f32x16 acc = f32x16{};
#pragma unroll 8
        for (int ks = 0; ks < 64; ++ks) {
            const bf16x8 a = *(const bf16x8*)(xrow + 16 * ks);
            bf16x8 w = *(const bf16x8*)(wrow + 16 * ks);
            if (r32 >= 8) w = bf16x8{};
            acc = mfma32(a, w, acc);
        }
        if (r32 < 8) {
#pragma unroll
            for (int r = 0; r < 16; ++r) accs[(wid * 32 + crow(r, hi)) * 8 + r32] = acc[r];
        }
    }
    __syncthreads();
    if (tid < 256) { const float rs = rstd_row(SS, row0 + tid);
#pragma unroll
        for (int h = 0; h < 8; ++h) { const float v = rs * accs[tid * 8 + h] + CF[h] + p.b_forget[l * 8 + h]; const float y = v * LOG2E;
            lf[h * 256 + tid] = -(fmaxf(-y, 0.f) + lg2(1.f + ex2(-fabsf(y)))); } }
    __syncthreads();
    { const int h = wid; f32x4 v = *(const LAS f32x4*)(lf + h * 256 + 4 * lane);
      v[1] += v[0]; v[2] += v[1]; v[3] += v[2];
      float run = v[3];
#pragma unroll
      for (int o = 1; o < 64; o <<= 1) { const float t = __shfl_up(run, o); if (lane >= o) run += t; }
      const float ex = run - v[3]; v = v + ex;
      const int bh = b * 8 + h;
      *(f32x4*)(CUM + (size_t)bh * SEQ + (row0 - b * SEQ) + 4 * lane) = v;
      if (lane == 63) TOT[bh * 32 + (unit & 31)] = run; }
    __syncthreads();
}

#ifndef DBG_STOP
#define DBG_STOP 0
#endif
__device__ __forceinline__ float bf2f(bf16_t v) { return __uint_as_float((unsigned)v << 16); }
__device__ __forceinline__ void dbg_dump(const Params& p, int stage) {
    const bf16_t* XB = (const bf16_t*)(p.ws + WS_XB); const bf16_t* PROJ = (const bf16_t*)(p.ws + WS_PROJ); const bf16_t* MIX = (const bf16_t*)(p.ws + WS_MIX); const bf16_t* HID = (const bf16_t*)(p.ws + WS_HID);
    const float* MOD = (const float*)(p.ws + WS_MOD); const float* CUM = (const float*)(p.ws + WS_CUM); const float* SS = (const float*)(p.ws + WS_SS);
    const bf16_t* WIN = (const bf16_t*)(p.ws + WS_WIN); const bf16_t* W1 = (const bf16_t*)(p.ws + WS_W1); const bf16_t* WOUT = (const bf16_t*)(p.ws + WS_WOUT); const bf16_t* W2 = (const bf16_t*)(p.ws + WS_W2);
    const float* CIN = (const float*)(p.ws + WS_CIN); const float* C1 = (const float*)(p.ws + WS_C1); const float* WF = (const float*)(p.ws + WS_WF);
    for (size_t i = (size_t)blockIdx.x * NTHREADS + threadIdx.x; i < (size_t)M * DM; i += (size_t)gridDim.x * NTHREADS) {
        const size_t m = i >> 10, n = i & 1023; float v = 0.f;
        if (stage == 1) v = bf2f(XB[i]) + MOD[i % 49152] + bf2f(WIN[i]) + bf2f(WIN[i + 16777216]) + bf2f(W1[i]) + bf2f(W1[i + 16777216]) + bf2f(WOUT[i % 4194304]) + bf2f(W2[i]) + CIN[i % 22528] + C1[i % 32768] + WF[i % 65536] + SS[i % 65536];
        if (stage == 2) v = bf2f(PROJ[m * NP + n]) + bf2f(PROJ[m * NP + 1024 + n]) + bf2f(PROJ[m * NP + 1792 + n]) + CUM[i % 131072];
        if (stage == 3) v = bf2f(MIX[i]);
        if (stage == 4) v = p.out[i] + bf2f(XB[i]) + SS[i % 65536];
        if (stage == 5) v = bf2f(HID[m * FF + n]) + bf2f(HID[m * FF + 1024 + n]) + bf2f(HID[m * FF + 2048 + n]) + bf2f(HID[m * FF + 3072 + n]);
        p.out[i] = v;
    }
}

__global__ void __launch_bounds__(NTHREADS, 2) fwd_megakernel(Params p) {
    extern __shared__ __attribute__((aligned(16))) unsigned char lds_raw[];
    LAS unsigned char* lds = (LAS unsigned char*)lds_raw;
    cg::grid_group grid = cg::this_grid();
    const int G = gridDim.x;
#ifndef PA_ALIGN
#define PA_ALIGN true
#endif
#ifndef PC2_ALIGN
#define PC2_ALIGN true
#endif
#ifndef REP_SYNC
#define REP_SYNC 1
#endif
#ifndef REP_PB
#define REP_PB 1
#endif
#ifndef REP_PRO
#define REP_PRO 1
#endif
#ifndef REP_PA
#define REP_PA 1
#endif
#define GRID_SYNC() do { for (int r_ = 0; r_ < REP_SYNC; ++r_) { xcd_barrier(xbar); } } while (0)
#define FRESH_TID() int tid = threadIdx.x; asm volatile("" : "+v"(tid))
    float* MOD = (float*)(p.ws + WS_MOD); float* SS = (float*)(p.ws + WS_SS);
    bf16_t* XB = (bf16_t*)(p.ws + WS_XB); bf16_t* PROJ = (bf16_t*)(p.ws + WS_PROJ); bf16_t* MIX = (bf16_t*)(p.ws + WS_MIX); bf16_t* HID = (bf16_t*)(p.ws + WS_HID);

    if (blockIdx.x == 0) for (int i = threadIdx.x; i < CTL_WORDS / 32; i += NTHREADS) __hip_atomic_store((unsigned*)(p.ws + WS_CTL) + 32 * i, 0u, __ATOMIC_RELAXED, __HIP_MEMORY_SCOPE_AGENT);
    volatile LAS unsigned* misc = (volatile LAS unsigned*)(lds + LDS_MISC);
    if (threadIdx.x < 2) misc[threadIdx.x] = 0u;
    asm volatile("s_waitcnt vmcnt(0)" ::: "memory"); __syncthreads(); grid.sync();
    XcdBarrier xbar = xcd_barrier_post((unsigned*)(p.ws + WS_CTL) + CW_BAR, misc);
    for (int r_ = 0; r_ < REP_PRO; ++r_) {
    { FRESH_TID(); p0_phase(p, lds, tid); }
    GRID_SYNC();
    { FRESH_TID(); p1_phase(p, lds, tid); }
    GRID_SYNC();
    }
    if (DBG_STOP == 1) { dbg_dump(p, 1); return; }

#pragma unroll 1
    for (int l = 0; l < DEPTH; ++l) {
        {
            pg8::Gemm g{XB, (const bf16_t*)(p.ws + WS_WIN) + (size_t)l * 2 * NP * DM, M, NP, DM, (size_t)NP * DM * 2};
            pg8::StaticOrder S; S.init(M, NP, G, (int)blockIdx.x);
            EpiIn E{PROJ, SS, (const float*)(p.ws + WS_CIN) + (size_t)l * 2 * NP, p.q_norm_g + l * 64, p.k_norm_g + l * 64, p.sgu_norm_g + l * 256};
            for (int r_ = 0; r_ < REP_PA; ++r_) { pg8::gemm_phase<EpiIn, pg8::StaticOrder, PA_ALIGN, true>(lds, g, S, E); __syncthreads(); }
            __syncthreads();
            const int nunits = (M / 256) * (NP / 256);
            const int first_light = nunits % G;
            for (int u = (int)blockIdx.x - first_light; u >= 0 && u < 64; u += (G - first_light)) {
#ifndef NO_FL
                { FRESH_TID(); fl_unit(p, l, u, lds, tid); }
#endif
            }
        }
        GRID_SYNC();
        if (DBG_STOP == 2) { dbg_dump(p, 2); return; }
#ifndef NO_PB
        for (int r_ = 0; r_ < REP_PB; ++r_) { if (r_) { if (blockIdx.x == 0 && threadIdx.x < 8) { __hip_atomic_store((unsigned*)(p.ws + WS_CTL) + 64 * (l * 8 + threadIdx.x), 0u, __ATOMIC_RELAXED, __HIP_MEMORY_SCOPE_AGENT); __hip_atomic_store((unsigned*)(p.ws + WS_CTL) + 64 * (32 + l * 8 + threadIdx.x), 0u, __ATOMIC_RELAXED, __HIP_MEMORY_SCOPE_AGENT); } GRID_SYNC(); } FRESH_TID(); mixers_phase(p, l, lds, tid); if (r_ + 1 < REP_PB) GRID_SYNC(); }
#endif
        GRID_SYNC();
        if (DBG_STOP == 3) { dbg_dump(p, 3); return; }
        {
            pg8::Gemm g{MIX, (const bf16_t*)(p.ws + WS_WOUT) + (size_t)l * DM * DM, M, DM, DM, 0};
            pg8::StaticOrder S; S.init(M, DM, G, (int)blockIdx.x);
            EpiRes E{l == 0 ? p.x : p.out, p.out, XB, SS, MOD + (size_t)l * 2 * 6144 + 2048};
#ifndef NO_PC1
            if (G == 256) pg8::gemm_phase<EpiRes, pg8::StaticOrder, false, true>(lds, g, S, E);
#endif
        }
        GRID_SYNC();
        if (DBG_STOP == 4) { dbg_dump(p, 4); return; }
        {
            pg8::Gemm g{XB, (const bf16_t*)(p.ws + WS_W1) + (size_t)l * 2 * FF * DM, M, FF, DM, (size_t)FF * DM * 2};
            pg8::StaticOrder S; S.init(M, FF, G, (int)blockIdx.x);
            EpiUp E{HID, SS, (const float*)(p.ws + WS_C1) + (size_t)l * 2 * FF};
#ifndef NO_PC2
            pg8::gemm_phase<EpiUp, pg8::StaticOrder, PC2_ALIGN, true>(lds, g, S, E);
#endif
        }
        GRID_SYNC();
        if (DBG_STOP == 5) { dbg_dump(p, 5); return; }
        {
            pg8::Gemm g{HID, (const bf16_t*)(p.ws + WS_W2) + (size_t)l * DM * FF, M, DM, FF, 0};
            pg8::StaticOrder S; S.init(M, DM, G, (int)blockIdx.x);
            EpiRes E{p.out, p.out, XB, SS, MOD + (size_t)l * 2 * 6144 + 5120};
#ifndef NO_PC3
            if (G == 256) pg8::gemm_phase<EpiRes, pg8::StaticOrder, false, true>(lds, g, S, E);
#endif
        }
        if (DBG_STOP == 6) return;
        if (l + 1 < DEPTH) GRID_SYNC();
    }
}

extern "C" void kernel_launch(void* const* d_in, const int* in_sizes, int n_in, void* d_out, int out_size, void* d_ws, size_t ws_size, hipStream_t stream) {
    static int grid_blocks = 0;
    if (grid_blocks == 0) {
        if (n_in != 16 || in_sizes[0] != M * DM || out_size != M * DM || ws_size < WS_END) { fprintf(stderr, "kernel_launch: unexpected shapes / workspace (%d inputs, ws %zu)\n", n_in, ws_size); grid_blocks = -1; return; }
        int dev = 0, cus = 0, per_cu = 0;
        hipGetDevice(&dev); hipDeviceGetAttribute(&cus, hipDeviceAttributeMultiprocessorCount, dev);
        if (hipFuncSetAttribute((const void*)fwd_megakernel, hipFuncAttributeMaxDynamicSharedMemorySize, LDS_BYTES) != hipSuccess) { fprintf(stderr, "kernel_launch: hipFuncSetAttribute failed\n"); grid_blocks = -1; return; }
        hipOccupancyMaxActiveBlocksPerMultiprocessor(&per_cu, (const void*)fwd_megakernel, NTHREADS, LDS_BYTES);
        (void)hipGetLastError();
        if (per_cu < 1) per_cu = 1;
        grid_blocks = cus;
        if (grid_blocks != 256) fprintf(stderr, "kernel_launch: %d CUs; the residual GEMM phases need a 256-workgroup grid\n", grid_blocks);
    }
    if (grid_blocks < 0) return;
    Params p{};
    p.x = (const float*)d_in[0]; p.c = (const float*)d_in[1]; p.ada_w = (const float*)d_in[2]; p.ada_b = (const float*)d_in[3]; p.norm1_g = (const float*)d_in[4]; p.norm2_g = (const float*)d_in[5];
    p.w_in = (const float*)d_in[6]; p.b_forget = (const float*)d_in[7]; p.q_norm_g = (const float*)d_in[8]; p.k_norm_g = (const float*)d_in[9]; p.sgu_norm_g = (const float*)d_in[10];
    p.sgu_w = (const float*)d_in[11]; p.sgu_b = (const float*)d_in[12]; p.w_out = (const float*)d_in[13]; p.mlp_w1 = (const float*)d_in[14]; p.mlp_w2 = (const float*)d_in[15];
    p.out = (float*)d_out; p.ws = (unsigned char*)d_ws;
    void* args[] = {&p};
    hipError_t e = hipLaunchCooperativeKernel((const void*)fwd_megakernel, dim3(grid_blocks), dim3(NTHREADS), args, LDS_BYTES, stream);
    if (e != hipSuccess) fprintf(stderr, "cooperative launch failed: %s (grid %d)\n", hipGetErrorString(e), grid_blocks);
}
```

```cpp
#include <hip/hip_runtime.h>
#include <hip/hip_cooperative_groups.h>
#include <cstdio>
#include <cstdint>
namespace cg = cooperative_groups;
namespace pg8 {
#define PG8_LAS __attribute__((address_space(3)))
typedef unsigned short bf16_t;
typedef short bf16x8 __attribute__((ext_vector_type(8)));
typedef float f32x4 __attribute__((ext_vector_type(4)));
typedef unsigned u32x4 __attribute__((ext_vector_type(4)));
constexpr int BM = 256, BK = 64, HALF = 128, HTB = HALF * BK * 2  , STAGE_BYTES = 8 * HTB, NXCD = 8, WGM = 8;

__host__ __device__ __forceinline__ int lds_byte(int r, int c) { const int st = (r >> 4) * 2 + (c >> 5), rr = r & 15, cc = c & 31, ob = rr * 64 + cc * 2; return st * 1024 + (ob ^ (((ob >> 9) & 1) << 5)); }
__host__ __device__ __forceinline__ void stage_rc(int b, int& R, int& C) { const int st = b / 1024, sb = b % 1024, swz = sb ^ (((sb >> 9) & 1) << 5); R = (st >> 1) * 16 + swz / 64; C = (st & 1) * 32 + (swz % 64) / 2; }
__host__ __device__ __forceinline__ int perm32(int rho) { const int n = rho >> 4, i = rho & 15; return 8 * (i >> 2) + 4 * n + (i & 3); }

struct Unit { int pm, pn; };
struct Gemm { const bf16_t* A; const bf16_t* Bt; int M, N, K; size_t bstride; };

struct StaticOrder {
    int nM, nN, nwg, G, c;
    __host__ __device__ void init(int M, int N, int G_, int c_) { nM = M / BM; nN = N / BM; nwg = nM * nN; G = G_; c = c_; }
    __host__ __device__ bool next(int i, Unit& u) const {
        const long L = (long)i * G + c; if (L >= nwg) return false;
        int wgid = (int)L; { const int q = nwg / NXCD, r = nwg % NXCD, xcd = wgid % NXCD, off = wgid / NXCD; wgid = (xcd < r ? xcd * (q + 1) : r * (q + 1) + (xcd - r) * q) + off; }
        const int nig = WGM * nN, gid = wgid / nig, fm = gid * WGM, gsz = (nM - fm) < WGM ? (nM - fm) : WGM;
        u.pm = fm + ((wgid % nig) % gsz); u.pn = (wgid % nig) / gsz; return true;
    }
    __device__ __forceinline__ void a_ready(const Unit&) const {}
    __device__ __forceinline__ void done(const Unit&) const {}
};

typedef float f32x2_cv __attribute__((ext_vector_type(2))); typedef __bf16 bf16x2_cv __attribute__((ext_vector_type(2)));
__device__ __forceinline__ unsigned cvt_pk_bf16(float lo, float hi) { f32x2_cv v = {lo, hi}; bf16x2_cv b = __builtin_convertvector(v, bf16x2_cv); return __builtin_bit_cast(unsigned, b); }
typedef float f32x2 __attribute__((ext_vector_type(2)));
template <class Epi, class Sched, bool ALIGN_EPI = false, bool SP2 = false>
__device__ __forceinline__ void gemm_phase(PG8_LAS unsigned char* lds, const Gemm g, const Sched& S, const Epi& E) {
    int tid_ = threadIdx.x; asm volatile("" : "+v"(tid_));
    const int tid = tid_, wid = __builtin_amdgcn_readfirstlane(tid >> 6), lane = tid & 63, wr = wid >> 2, wc = wid & 3, fr = lane & 15, fq = lane >> 4;
    const int K = g.K, nt = K / BK;
    unsigned voffA[2], voffB[2];
#pragma unroll
    for (int i = 0; i < 2; ++i) { int R, C; stage_rc(tid * 16 + i * 8192, R, C); const int Rb = Epi::PERM ? ((R & ~31) + perm32(R & 31)) : R;
        voffA[i] = (unsigned)(R * K + C) * 2u; voffB[i] = (unsigned)(Rb * K + C) * 2u; }
    const size_t kstep = (size_t)(BK * 2);
    const size_t hstep = (size_t)HALF * K * 2;
    const size_t tstep = 2 * hstep;
    const unsigned ldsw = (unsigned)wid * 1024u;
    const int aoff = lds_byte(wr * 64 + fr, fq * 8), boff = lds_byte(wc * 32 + fr, fq * 8);
#define PG8_SA(b, h) (((b) * 2 + (h)) * HTB)
#define PG8_SB(b, h) ((4 + (b) * 2 + (h)) * HTB)
#define PG8_STAGE(bufoff, gbase, voff) do { _Pragma("unroll") for (int _i = 0; _i < 2; ++_i) \
        __builtin_amdgcn_global_load_lds((const unsigned*)((const char*)(gbase) + (voff)[_i]), (PG8_LAS unsigned*)(lds + (bufoff) + ldsw + _i * 8192), 16, 0, 0); } while (0)
#define PG8_LDA(dst, b, h) do { _Pragma("unroll") for (int m = 0; m < 4; ++m) _Pragma("unroll") for (int k = 0; k < 2; ++k) dst[m][k] = *(const PG8_LAS bf16x8*)(lds + PG8_SA(b, h) + aoff + m * 2048 + k * 1024); } while (0)
#define PG8_LDB(dst, b, h) do { _Pragma("unroll") for (int n = 0; n < 2; ++n) _Pragma("unroll") for (int k = 0; k < 2; ++k) dst[n][k] = *(const PG8_LAS bf16x8*)(lds + PG8_SB(b, h) + boff + n * 2048 + k * 1024); } while (0)
#define PG8_MMA(ai, bj, At, Bt) do { __builtin_amdgcn_s_setprio(1); _Pragma("unroll") for (int m = 0; m < 4; ++m) _Pragma("unroll") for (int n = 0; n < 2; ++n) _Pragma("unroll") for (int k = 0; k < 2; ++k) \
        acc[ai][bj][m][n] = __builtin_amdgcn_mfma_f32_16x16x32_bf16(Bt[n][k], At[m][k], acc[ai][bj][m][n], 0, 0, 0); __builtin_amdgcn_s_setprio(0); } while (0)
#define PG8_WAIT_V(n) asm volatile("s_waitcnt vmcnt(" #n ")" ::: "memory")
#define PG8_WAIT_L(n) asm volatile("s_waitcnt lgkmcnt(" #n ")" ::: "memory")
#define PG8_BAR __builtin_amdgcn_s_barrier()
#define PG8_SCHED __builtin_amdgcn_sched_barrier(0)
    Unit cur, nxt; int ui = 0;
    if (!S.next(0, cur)) return;
    f32x4 acc[2][2][4][2];
#pragma unroll
    for (int a = 0; a < 2; ++a)
#pragma unroll
        for (int b = 0; b < 2; ++b)
#pragma unroll
            for (int m = 0; m < 4; ++m)
#pragma unroll
                for (int n = 0; n < 2; ++n) acc[a][b][m][n] = (f32x4){0.f, 0.f, 0.f, 0.f};
    bf16x8 At[4][2], B0[2][2], B1[2][2];
    const char* cA = (const char*)g.A + (size_t)cur.pm * tstep; const char* cB = (const char*)g.Bt + (size_t)cur.pn * tstep + (size_t)(cur.pm >> 5) * g.bstride;
    S.a_ready(cur);
    if constexpr (SP2) {
        PG8_STAGE(PG8_SB(0, 0), cB, voffB); PG8_STAGE(PG8_SB(0, 1), cB + hstep, voffB); PG8_STAGE(PG8_SA(0, 0), cA, voffA); PG8_STAGE(PG8_SA(0, 1), cA + hstep, voffA);
        if (wr == 1) PG8_BAR;
        PG8_WAIT_V(2); PG8_BAR;
        PG8_STAGE(PG8_SB(1, 0), cB + kstep, voffB); PG8_STAGE(PG8_SA(1, 0), cA + kstep, voffA); PG8_STAGE(PG8_SB(1, 1), cB + hstep + kstep, voffB);
        PG8_WAIT_V(6); PG8_BAR;
    } else {
        PG8_STAGE(PG8_SB(0, 0), cB, voffB); PG8_STAGE(PG8_SA(0, 0), cA, voffA); PG8_STAGE(PG8_SB(0, 1), cB + hstep, voffB); PG8_STAGE(PG8_SA(0, 1), cA + hstep, voffA);
        if (wr == 1) PG8_BAR;
        PG8_WAIT_V(4); PG8_BAR;
        PG8_STAGE(PG8_SB(1, 0), cB + kstep, voffB); PG8_STAGE(PG8_SA(1, 0), cA + kstep, voffA); PG8_STAGE(PG8_SB(1, 1), cB + hstep + kstep, voffB);
        PG8_WAIT_V(6); PG8_BAR;
    }
    for (;;) {
        const bool has_next = S.next(ui + 1, nxt);
        const char* nA = has_next ? (const char*)g.A + (size_t)nxt.pm * tstep : cA; const char* nB = has_next ? (const char*)g.Bt + (size_t)nxt.pn * tstep + (size_t)(nxt.pm >> 5) * g.bstride : cB;
        for (int t = 0; t < nt; t += 2) {
            const bool last = (t == nt - 2);
            const char* a1 = cA + (size_t)(t + 1) * kstep;
            const char* a2 = last ? nA : cA + (size_t)(t + 2) * kstep; const char* b2 = last ? nB : cB + (size_t)(t + 2) * kstep;
            const char* a3 = a2 + kstep; const char* b3 = b2 + kstep;
            if (last && has_next) S.a_ready(nxt);
            if constexpr (SP2) {
            PG8_LDB(B0, 0, 0); PG8_LDB(B1, 0, 1); PG8_SCHED; PG8_LDA(At, 0, 0); PG8_STAGE(PG8_SA(1, 1), a1 + hstep, voffA);
            PG8_WAIT_V(8); PG8_WAIT_L(0); PG8_BAR; PG8_MMA(0, 0, At, B0); PG8_MMA(0, 1, At, B1); PG8_BAR; PG8_SCHED;
            PG8_LDA(At, 0, 1); PG8_STAGE(PG8_SB(0, 0), b2, voffB); PG8_STAGE(PG8_SB(0, 1), b2 + hstep, voffB); PG8_STAGE(PG8_SA(0, 0), a2, voffA);
            PG8_WAIT_V(8); PG8_WAIT_L(0); PG8_BAR; PG8_MMA(1, 0, At, B0); PG8_MMA(1, 1, At, B1); PG8_BAR; PG8_SCHED;
            PG8_LDB(B0, 1, 0); PG8_LDB(B1, 1, 1); PG8_SCHED; PG8_LDA(At, 1, 0); PG8_STAGE(PG8_SA(0, 1), a2 + hstep, voffA);
            PG8_WAIT_V(8); PG8_WAIT_L(0); PG8_BAR; PG8_MMA(0, 0, At, B0); PG8_MMA(0, 1, At, B1); PG8_BAR; PG8_SCHED;
            PG8_LDA(At, 1, 1); PG8_STAGE(PG8_SB(1, 0), b3, voffB); PG8_STAGE(PG8_SB(1, 1), b3 + hstep, voffB); PG8_STAGE(PG8_SA(1, 0), a3, voffA);
            PG8_WAIT_V(8); PG8_WAIT_L(0); PG8_BAR; PG8_MMA(1, 0, At, B0); PG8_MMA(1, 1, At, B1); PG8_BAR; PG8_SCHED;
            } else {
            PG8_LDB(B0, 0, 0); PG8_SCHED; PG8_LDA(At, 0, 0); PG8_STAGE(PG8_SA(1, 1), a1 + hstep, voffA);
            PG8_WAIT_L(8); PG8_BAR; PG8_WAIT_L(0); PG8_MMA(0, 0, At, B0); PG8_BAR; PG8_SCHED;
            PG8_LDB(B1, 0, 1); PG8_STAGE(PG8_SB(0, 0), b2, voffB);
            PG8_BAR; PG8_WAIT_L(0); PG8_MMA(0, 1, At, B1); PG8_BAR;
            PG8_LDA(At, 0, 1); PG8_STAGE(PG8_SA(0, 0), a2, voffA);
            PG8_BAR; PG8_WAIT_L(0); PG8_MMA(1, 0, At, B0); PG8_BAR; PG8_SCHED;
            PG8_STAGE(PG8_SB(0, 1), b2 + hstep, voffB);
            PG8_WAIT_V(6); PG8_BAR; PG8_MMA(1, 1, At, B1); PG8_BAR;
            PG8_LDB(B0, 1, 0); PG8_SCHED; PG8_LDA(At, 1, 0); PG8_STAGE(PG8_SA(0, 1), a2 + hstep, voffA);
            PG8_WAIT_L(8); PG8_BAR; PG8_WAIT_L(0); PG8_MMA(0, 0, At, B0); PG8_BAR; PG8_SCHED;
            PG8_LDB(B1, 1, 1); PG8_STAGE(PG8_SB(1, 0), b3, voffB);
            PG8_BAR; PG8_WAIT_L(0); PG8_MMA(0, 1, At, B1); PG8_BAR;
            PG8_LDA(At, 1, 1); PG8_STAGE(PG8_SA(1, 0), a3, voffA);
            PG8_BAR; PG8_WAIT_L(0); PG8_MMA(1, 0, At, B0); PG8_BAR; PG8_SCHED;
            PG8_STAGE(PG8_SB(1, 1), b3 + hstep, voffB);
            PG8_WAIT_V(6); PG8_BAR; PG8_MMA(1, 1, At, B1); PG8_BAR;
            }
        }
        if constexpr (ALIGN_EPI) { if (wr == 0) PG8_BAR; }
        if constexpr (!Epi::AFTER_DRAIN) { E(acc, cur, wr, wc, fr, fq); S.done(cur); }
        if (!has_next) break;
#pragma unroll
        for (int a = 0; a < 2; ++a)
#pragma unroll
            for (int b = 0; b < 2; ++b)
#pragma unroll
                for (int m = 0; m < 4; ++m)
#pragma unroll
                    for (int n = 0; n < 2; ++n) acc[a][b][m][n] = (f32x4){0.f, 0.f, 0.f, 0.f};
        cur = nxt; cA = nA; cB = nB; ++ui;
        if constexpr (ALIGN_EPI) { if (wr == 1) PG8_BAR; }
    }
    PG8_WAIT_V(0);
    if constexpr (!ALIGN_EPI) { if (wr == 0) PG8_BAR; }
    PG8_BAR;
    if constexpr (Epi::AFTER_DRAIN) { E.fused(acc, cur, wr, wc, fr, fq, lds, wid, lane); S.done(cur); }
#undef PG8_SA
#undef PG8_SB
#undef PG8_STAGE
#undef PG8_LDA
#undef PG8_LDB
#undef PG8_MMA
#undef PG8_WAIT_V
#undef PG8_WAIT_L
#undef PG8_BAR
#undef PG8_SCHED
}
}
#define LAS __attribute__((address_space(3)))
using pg8::bf16_t; using pg8::bf16x8; using pg8::f32x4; using pg8::u32x4; using pg8::Unit; using pg8::cvt_pk_bf16;
typedef float f32x16 __attribute__((ext_vector_type(16)));
typedef short s16x4 __attribute__((ext_vector_type(4)));
typedef unsigned u32x2 __attribute__((ext_vector_type(2)));

constexpr int BATCH = 2, SEQ = 8192, DM = 1024, FF = 4096, DEPTH = 4, M = BATCH * SEQ;
constexpr int INW = 2824, NP = 2816;
constexpr int C_QA = 0, C_KA = 256, C_VA = 512, C_QB = 768, C_KB = 1280, C_VB = 1792, C_UC = 2304, C_VC = 2560;
constexpr float EPS = 1e-6f, LOG2E = 1.4426950408889634f, C2 = 0.125f * LOG2E;
constexpr float ZERO_CUT = -150.0f;

constexpr size_t MiB = 1u << 20;
constexpr size_t WS_CTL = 0;
constexpr size_t WS_MOD = 64 * 1024;
constexpr size_t WS_CIN = WS_MOD + 196608;
constexpr size_t WS_C1 = WS_CIN + 90112;
constexpr size_t WS_CF = WS_C1 + 131072;
constexpr size_t WS_WF = WS_CF + 256;
constexpr size_t WS_TOT = WS_WF + 262144;
constexpr size_t WS_CUM = 1 * MiB;
constexpr size_t WS_SS = 2 * MiB;
constexpr size_t WS_XB = 4 * MiB;
constexpr size_t WS_WIN = 36 * MiB;
constexpr size_t WS_W1 = 80 * MiB;
constexpr size_t WS_WOUT = 144 * MiB;
constexpr size_t WS_W2 = 152 * MiB;
constexpr size_t WS_HID = 184 * MiB;
constexpr size_t WS_PROJ = 184 * MiB;
constexpr size_t WS_MIX = 272 * MiB;
constexpr size_t WS_END = 312 * MiB;

constexpr int NTHREADS = 512, NWAVES = 8;
constexpr int LDS_BYTES = 147456;
constexpr int LDS_MISC = 143360;
constexpr int CW_BAR = 8192, CTL_WORDS = CW_BAR + 3456;

struct Params {
    const float *x, *c, *ada_w, *ada_b, *norm1_g, *norm2_g, *w_in, *b_forget, *q_norm_g, *k_norm_g, *sgu_norm_g, *sgu_w, *sgu_b, *w_out, *mlp_w1, *mlp_w2;
    float* out; unsigned char* ws;
};

__device__ __forceinline__ float ex2(float v) { return __builtin_amdgcn_exp2f(v); }
__device__ __forceinline__ float lg2(float v) { return __builtin_amdgcn_logf(v); }
__device__ __forceinline__ float softplus2(float z) { return fmaxf(z, 0.f) + lg2(1.f + ex2(-fabsf(z))); }
__device__ __forceinline__ float gelu_tanh(float v) { const float u = 0.7978845608028654f * (v + 0.044715f * v * v * v); return v * __builtin_amdgcn_rcpf(1.f + ex2(-2.f * LOG2E * u)); }
__device__ __forceinline__ float rstd_row(const float* SS, int row) {
    const float s = (SS[row] + SS[M + row]) + (SS[2 * M + row] + SS[3 * M + row]);
    return __builtin_amdgcn_rsqf(s * (1.f / DM) + EPS);
}
__device__ __forceinline__ float wave_sum(float v) {
#pragma unroll
    for (int o = 1; o < 64; o <<= 1) v += __shfl_xor(v, o);
    return v;
}
__device__ __forceinline__ float wave_max(float v) {
#pragma unroll
    for (int o = 1; o < 64; o <<= 1) v = fmaxf(v, __shfl_xor(v, o));
    return v;
}


struct EpiIn {
    static constexpr bool PERM = true, AFTER_DRAIN = false;
    bf16_t* P; const float* SS; const float* cin; const float* qg; const float* kg; const float* sg;
    __device__ __forceinline__ void operator()(const f32x4 (&acc)[2][2][4][2], const Unit& u, int wr, int wc, int fr, int fq) const {
        const int b = u.pm >> 5, pn = u.pn;
        const int colw = pn * 256 + 64 * wc + 8 * fq;
        int type;
        const float* gain = nullptr;
        if (pn == 0) type = 1; else if (pn <= 2) type = 0; else if (pn <= 4) { type = 2; gain = qg; } else if (pn <= 6) { type = 3; gain = kg; }
        else if (pn <= 8) type = 0; else if (pn == 9) type = 4; else { type = 5; gain = sg + 64 * wc; }
        f32x4 cb[2][2], gv[2][2];
#pragma unroll
        for (int bj = 0; bj < 2; ++bj)
#pragma unroll
            for (int n = 0; n < 2; ++n) {
                cb[bj][n] = *(const f32x4*)(cin + b * NP + colw + 32 * bj + 4 * n);
                gv[bj][n] = gain ? *(const f32x4*)(gain + 32 * bj + 8 * fq + 4 * n) : (f32x4){1.f, 1.f, 1.f, 1.f};
                if (type == 2) gv[bj][n] = gv[bj][n] * C2;
            }
#pragma unroll
        for (int ai = 0; ai < 2; ++ai)
#pragma unroll
            for (int m = 0; m < 4; ++m) {
                const int row = u.pm * 256 + ai * 128 + wr * 64 + m * 16 + fr;
                const float rs = rstd_row(SS, row);
                f32x4 v[2][2]; float ss = 0.f;
#pragma unroll
                for (int bj = 0; bj < 2; ++bj)
#pragma unroll
                    for (int n = 0; n < 2; ++n) {
                        f32x4 t = acc[ai][bj][m][n] * rs + cb[bj][n];
                        if (type >= 4) { t[0] = gelu_tanh(t[0]); t[1] = gelu_tanh(t[1]); t[2] = gelu_tanh(t[2]); t[3] = gelu_tanh(t[3]); }
                        if (type == 1) t = t * C2;
                        v[bj][n] = t; ss += (t[0] * t[0] + t[1] * t[1]) + (t[2] * t[2] + t[3] * t[3]);
                    }
                if (type == 2 || type == 3 || type == 5) {
                    ss += __shfl_xor(ss, 16); ss += __shfl_xor(ss, 32);
                    const float r = __builtin_amdgcn_rsqf(ss * (1.f / 64.f) + EPS);
#pragma unroll
                    for (int bj = 0; bj < 2; ++bj)
#pragma unroll
                        for (int n = 0; n < 2; ++n) v[bj][n] = v[bj][n] * r * gv[bj][n];
                }
                bf16_t* rowp = P + (size_t)row * NP + colw;
#pragma unroll
                for (int bj = 0; bj < 2; ++bj) {
                    u32x4 w; w.x = cvt_pk_bf16(v[bj][0][0], v[bj][0][1]); w.y = cvt_pk_bf16(v[bj][0][2], v[bj][0][3]); w.z = cvt_pk_bf16(v[bj][1][0], v[bj][1][1]); w.w = cvt_pk_bf16(v[bj][1][2], v[bj][1][3]);
                    *(u32x4*)(rowp + 32 * bj) = w;
                }
            }
    }
};

struct EpiUp {
    static constexpr bool PERM = true, AFTER_DRAIN = false;
    bf16_t* H; const float* SS; const float* c1;
    __device__ __forceinline__ void operator()(const f32x4 (&acc)[2][2][4][2], const Unit& u, int wr, int wc, int fr, int fq) const {
        const int b = u.pm >> 5;
        const int colw = u.pn * 256 + 64 * wc + 8 * fq;
        f32x4 cb[2][2];
#pragma unroll
        for (int bj = 0; bj < 2; ++bj)
#pragma unroll
            for (int n = 0; n < 2; ++n) cb[bj][n] = *(const f32x4*)(c1 + b * FF + colw + 32 * bj + 4 * n);
#pragma unroll
        for (int ai = 0; ai < 2; ++ai)
#pragma unroll
            for (int m = 0; m < 4; ++m) {
                const int row = u.pm * 256 + ai * 128 + wr * 64 + m * 16 + fr;
                const float rs = rstd_row(SS, row);
                bf16_t* rowp = H + (size_t)row * FF + colw;
#pragma unroll
                for (int bj = 0; bj < 2; ++bj) {
                    f32x4 a = acc[ai][bj][m][0] * rs + cb[bj][0], c = acc[ai][bj][m][1] * rs + cb[bj][1];
#pragma unroll
                    for (int e = 0; e < 4; ++e) { const float x = fmaxf(a[e], 0.f), y = fmaxf(c[e], 0.f); a[e] = x * x; c[e] = y * y; }
                    u32x4 w; w.x = cvt_pk_bf16(a[0], a[1]); w.y = cvt_pk_bf16(a[2], a[3]); w.z = cvt_pk_bf16(c[0], c[1]); w.w = cvt_pk_bf16(c[2], c[3]);
                    *(u32x4*)(rowp + 32 * bj) = w;
                }
            }
    }
};

struct EpiRes {
    static constexpr bool PERM = true, AFTER_DRAIN = true;
    const float* base; float* out; bf16_t* xb; float* SS; const float* gate;
    __device__ __forceinline__ void fused(f32x4 (&acc)[2][2][4][2], const Unit& u, int wr, int wc, int fr, int fq, LAS unsigned char* lds, int wid, int lane) const {
        const int b = u.pm >> 5;
        const int colw = u.pn * 256 + 64 * wc + 8 * fq;
        LAS float* Pl = (LAS float*)lds;
        f32x4 gt[2][2];
#pragma unroll
        for (int bj = 0; bj < 2; ++bj)
#pragma unroll
            for (int n = 0; n < 2; ++n) gt[bj][n] = *(const f32x4*)(gate + b * 6144 + colw + 32 * bj + 4 * n);
#pragma unroll
        for (int ai = 0; ai < 2; ++ai)
#pragma unroll
            for (int m = 0; m < 4; ++m) {
                const int rl = ai * 128 + wr * 64 + m * 16 + fr; const size_t off = (size_t)(u.pm * 256 + rl) * DM + colw; float ss = 0.f;
#pragma unroll
                for (int bj = 0; bj < 2; ++bj) {
                    const f32x4 x0 = *(const f32x4*)(base + off + 32 * bj), x1 = *(const f32x4*)(base + off + 32 * bj + 4);
                    const f32x4 a = x0 + gt[bj][0] * acc[ai][bj][m][0], c = x1 + gt[bj][1] * acc[ai][bj][m][1];
                    *(f32x4*)(out + off + 32 * bj) = a; *(f32x4*)(out + off + 32 * bj + 4) = c;
                    u32x4 w; w.x = cvt_pk_bf16(a[0], a[1]); w.y = cvt_pk_bf16(a[2], a[3]); w.z = cvt_pk_bf16(c[0], c[1]); w.w = cvt_pk_bf16(c[2], c[3]);
                    *(u32x4*)(xb + off + 32 * bj) = w;
                    ss += ((a[0] * a[0] + a[1] * a[1]) + (a[2] * a[2] + a[3] * a[3])) + ((c[0] * c[0] + c[1] * c[1]) + (c[2] * c[2] + c[3] * c[3]));
                }
                ss += __shfl_xor(ss, 16); ss += __shfl_xor(ss, 32);
                if (fq == 0) Pl[rl * 4 + wc] = ss;
            }
        __syncthreads();
        const int tid = wid * 64 + lane;
        if (tid < 256) { const f32x4 p = *(const LAS f32x4*)(Pl + tid * 4); SS[(size_t)u.pn * M + u.pm * 256 + tid] = (p[0] + p[1]) + (p[2] + p[3]); }
        __syncthreads();
    }
};
typedef unsigned v4u_xb __attribute__((ext_vector_type(4)));
#define XB_TMO      128
#define XB_XCNT(j)  (256  + 64 * (j))
#define XB_XSUB(j)  (1280 + 64 * (j))
#define XB_XGEN(j)  (2304 + 64 * (j))
#define XB_TOP      3328
#define XB_TOPGEN   3392
#define XCD_BAR_WORDS 3456
#define XB_SPIN_CAP (1u << 18)

__device__ __forceinline__ unsigned xb_ld(unsigned* p)              { return __hip_atomic_load(p, __ATOMIC_RELAXED, __HIP_MEMORY_SCOPE_AGENT); }
__device__ __forceinline__ unsigned xb_add(unsigned* p, unsigned v) { return __hip_atomic_fetch_add(p, v, __ATOMIC_RELAXED, __HIP_MEMORY_SCOPE_AGENT); }
__device__ __forceinline__ unsigned xb_xcc_id() { return (unsigned)__builtin_amdgcn_s_getreg((3 << 11) | 20) & 0xFu; }
#define XB_SPIN(cond, bar) do { unsigned _sp = 0; while (cond) { __builtin_amdgcn_s_sleep(1); \
    if ((++_sp & 255u) == 0u) { if (xb_ld(&(bar)[XB_TMO])) break; if (_sp > XB_SPIN_CAP) { atomicAdd(&(bar)[XB_TMO], 1u); break; } } } } while (0)

struct XcdBarrier {
    unsigned* bar; unsigned x;
    volatile LAS unsigned* st;
};

__device__ __forceinline__ XcdBarrier xcd_barrier_post(unsigned* bar, volatile LAS unsigned* st) {
    XcdBarrier b; b.bar = bar; b.x = xb_xcc_id(); b.st = st;
    if (threadIdx.x == 0) (void)xb_add(&bar[XB_XCNT(b.x)], 1u);
    return b;
}
__device__ __forceinline__ void xcd_barrier_complete(unsigned* bar, unsigned x, unsigned& nloc, unsigned& nx) {
    const unsigned G = gridDim.x * gridDim.y * gridDim.z;
    unsigned sum, cnt, mine, sp = 0u;
    for (;;) {
        sum = 0u; cnt = 0u; mine = 0u;
#pragma unroll
        for (unsigned j = 0; j < 16; ++j) { const unsigned c = xb_ld(&bar[XB_XCNT(j)]); sum += c; cnt += (c > 0u) ? 1u : 0u; mine = (j == x) ? c : mine; }
        if (sum == G) break;
        __builtin_amdgcn_s_sleep(1);
        if ((++sp & 255u) == 0u) { if (xb_ld(&bar[XB_TMO])) break; if (sp > XB_SPIN_CAP) { atomicAdd(&bar[XB_TMO], 1u); break; } }
    }
    nloc = mine > 0u ? mine : 1u; nx = cnt > 0u ? cnt : 1u;
}

__device__ __forceinline__ void xcd_barrier(const XcdBarrier& b) {
    asm volatile("s_waitcnt vmcnt(0)" ::: "memory");
    __syncthreads();
    if (threadIdx.x == 0) {
        unsigned* bar = b.bar;
        __builtin_amdgcn_s_waitcnt(0);
        unsigned nloc = b.st[0], nx = b.st[1];
        if (nloc == 0u) { xcd_barrier_complete(bar, b.x, nloc, nx); b.st[0] = nloc; b.st[1] = nx; }
        const unsigned old = xb_add(&bar[XB_XSUB(b.x)], 1u);
        const unsigned gen = old / nloc;
        if (old + 1u == (gen + 1u) * nloc) {
            __builtin_amdgcn_fence(__ATOMIC_RELEASE, "agent");
            asm volatile("s_waitcnt vmcnt(0)" ::: "memory");
            const unsigned og = xb_add(&bar[XB_TOP], 1u);
            const unsigned tg = og / nx;
            if (og + 1u == (tg + 1u) * nx) xb_add(&bar[XB_TOPGEN], 1u);
            else XB_SPIN(xb_ld(&bar[XB_TOPGEN]) == tg, bar);
            __builtin_amdgcn_fence(__ATOMIC_ACQUIRE, "agent");
            xb_add(&bar[XB_XGEN(b.x)], 1u);
            asm volatile("s_waitcnt vmcnt(0)" ::: "memory");
        } else {
            XB_SPIN(xb_ld(&bar[XB_XGEN(b.x)]) == gen, bar);
            __builtin_amdgcn_fence(__ATOMIC_ACQUIRE, "agent");
            asm volatile("s_waitcnt vmcnt(0)" ::: "memory");
        }
    }
    __syncthreads();
}
#ifndef FOX_CUT
#define FOX_CUT ZERO_CUT
#endif
constexpr int KCH = 1040, WL_K = 0, WL_V = 8320, VDH = 4160, WL_WSF = 16640, WL_CUM = 16896, WL_BYTES = 17152;
__device__ __forceinline__ int crow(int r, int hi) { return (r & 3) + 8 * (r >> 2) + 4 * hi; }
__device__ __forceinline__ f32x16 mfma32(bf16x8 a, bf16x8 b, f32x16 c) { return __builtin_amdgcn_mfma_f32_32x32x16_bf16(a, b, c, 0, 0, 0); }
__device__ __forceinline__ s16x4 vtr(const LAS unsigned char* p) { return __builtin_bit_cast(s16x4, __builtin_amdgcn_ds_read_tr16_b64_v4i16((LAS s16x4*)p)); }
__device__ __forceinline__ float swap_sum(float v, float& partner, int hi) {
    auto rr = __builtin_amdgcn_permlane32_swap(__float_as_uint(v), __float_as_uint(v), false, false);
    const float a = __uint_as_float(rr[0]), b = __uint_as_float(rr[1]); partner = hi ? a : b; return a + b;
}
__device__ __forceinline__ float swap_max(float v) {
    auto rr = __builtin_amdgcn_permlane32_swap(__float_as_uint(v), __float_as_uint(v), false, false);
    return fmaxf(__uint_as_float(rr[0]), __uint_as_float(rr[1]));
}

struct TileRegs { u32x4 kv[8], vv[8]; };
template <bool WITH_K>
__device__ __forceinline__ void issue_tile(TileRegs& R, const bf16_t* Kg, const bf16_t* Vg, int lane) {
    const int k8 = lane >> 3, ch = lane & 7;
#pragma unroll
    for (int i = 0; i < 8; ++i) { const int key = k8 + 8 * i;
        if (WITH_K) R.kv[i] = *(const u32x4*)(Kg + (size_t)key * NP + ch * 8);
        R.vv[i] = *(const u32x4*)(Vg + (size_t)key * NP + ch * 8); }
}
template <bool WITH_K>
__device__ __forceinline__ void store_tile(LAS unsigned char* wl, const TileRegs& R, int lane) {
    const int k8 = lane >> 3, ch = lane & 7;
#pragma unroll
    for (int i = 0; i < 8; ++i) { const int key = k8 + 8 * i;
        if (WITH_K) *(LAS u32x4*)(wl + WL_K + ch * KCH + key * 16) = R.kv[i];
        *(LAS u32x4*)(wl + WL_V + (ch >> 2) * VDH + (key >> 4) * 1024 + (key & 15) * 64 + (ch & 3) * 16) = R.vv[i]; }
}
template <bool WITH_K>
__device__ __forceinline__ void load_tile(LAS unsigned char* wl, const bf16_t* Kg, const bf16_t* Vg, int lane) { TileRegs R; issue_tile<WITH_K>(R, Kg, Vg, lane); store_tile<WITH_K>(wl, R, lane); }
__device__ __forceinline__ void qk(f32x16& p0, f32x16& p1, const LAS unsigned char* wl, const bf16x8* qr, int r32, int hi) {
    const LAS unsigned char* kp = wl + WL_K + hi * KCH + r32 * 16;
#pragma unroll
    for (int d0 = 0; d0 < 4; ++d0) {
        const bf16x8 a0 = *(const LAS bf16x8*)(kp + d0 * 2 * KCH), a1 = *(const LAS bf16x8*)(kp + d0 * 2 * KCH + 512);
        p0 = mfma32(a0, qr[d0], p0); p1 = mfma32(a1, qr[d0], p1);
    }
}
__device__ __forceinline__ void pack_p(u32x4* pw, const f32x16& p0, const f32x16& p1) {
    pw[0] = (u32x4){cvt_pk_bf16(p0[0], p0[1]), cvt_pk_bf16(p0[2], p0[3]), cvt_pk_bf16(p0[4], p0[5]), cvt_pk_bf16(p0[6], p0[7])};
    pw[1] = (u32x4){cvt_pk_bf16(p0[8], p0[9]), cvt_pk_bf16(p0[10], p0[11]), cvt_pk_bf16(p0[12], p0[13]), cvt_pk_bf16(p0[14], p0[15])};
    pw[2] = (u32x4){cvt_pk_bf16(p1[0], p1[1]), cvt_pk_bf16(p1[2], p1[3]), cvt_pk_bf16(p1[4], p1[5]), cvt_pk_bf16(p1[6], p1[7])};
    pw[3] = (u32x4){cvt_pk_bf16(p1[8], p1[9]), cvt_pk_bf16(p1[10], p1[11]), cvt_pk_bf16(p1[12], p1[13]), cvt_pk_bf16(p1[14], p1[15])};
}
__device__ __forceinline__ void pv(f32x16* o, const LAS unsigned char* wl, int lane, int hi, const u32x4* pw) {
    const LAS unsigned char* vp = wl + WL_V + ((lane >> 4) & 1) * 32 + (lane & 3) * 8 + (4 * hi + ((lane & 15) >> 2)) * 64;
#pragma unroll
    for (int d0 = 0; d0 < 2; ++d0)
#pragma unroll
        for (int ks = 0; ks < 4; ++ks) {
            const s16x4 lo = vtr(vp + d0 * VDH + ks * 1024), hh = vtr(vp + d0 * VDH + ks * 1024 + 512);
            const bf16x8 vf = (bf16x8){lo[0], lo[1], lo[2], lo[3], hh[0], hh[1], hh[2], hh[3]};
            o[d0] = mfma32(__builtin_bit_cast(bf16x8, pw[ks]), vf, o[d0]);
        }
}
__device__ __forceinline__ void emit_o(const f32x16* o, LAS unsigned char* wl, int lane, int r32, int hi, bf16_t* dst  , const bf16_t* gate  ) {
    LAS float* stg = (LAS float*)(wl + WL_K);
#pragma unroll
    for (int r = 0; r < 16; ++r) { const int orow = crow(r, hi);
#pragma unroll
        for (int d0 = 0; d0 < 2; ++d0) stg[orow * 64 + d0 * 32 + r32] = o[d0][r]; }
#pragma unroll
    for (int i = 0; i < 4; ++i) { const int row = i * 8 + (lane >> 3), ch = lane & 7;
        f32x4 a = *(const LAS f32x4*)(stg + row * 64 + ch * 8), c = *(const LAS f32x4*)(stg + row * 64 + ch * 8 + 4);
        if (gate) { const u32x4 g = *(const u32x4*)(gate + (size_t)row * NP + ch * 8);
            a[0] *= __uint_as_float(g.x << 16); a[1] *= __uint_as_float(g.x & 0xffff0000u); a[2] *= __uint_as_float(g.y << 16); a[3] *= __uint_as_float(g.y & 0xffff0000u);
            c[0] *= __uint_as_float(g.z << 16); c[1] *= __uint_as_float(g.z & 0xffff0000u); c[2] *= __uint_as_float(g.w << 16); c[3] *= __uint_as_float(g.w & 0xffff0000u); }
        u32x4 w; w.x = cvt_pk_bf16(a[0], a[1]); w.y = cvt_pk_bf16(a[2], a[3]); w.z = cvt_pk_bf16(c[0], c[1]); w.w = cvt_pk_bf16(c[2], c[3]);
        *(u32x4*)(dst + (size_t)row * DM + ch * 8) = w; }
}

__device__ __forceinline__ void fox_item(LAS unsigned char* wl, int lane, const bf16_t* PROJ, bf16_t* MIX, const float* CUM, const float* TOT, float zmax2, int bh, int qblk) {
    const int r32 = lane & 31, hi = lane >> 5, b = bh >> 3, h = bh & 7, t0 = qblk * 32;
    const size_t rowb = (size_t)b * SEQ;
    const bf16_t* Qg = PROJ + (rowb + t0 + r32) * NP + C_QB + h * 64;
    bf16x8 qr[4];
#pragma unroll
    for (int d0 = 0; d0 < 4; ++d0) qr[d0] = *(const bf16x8*)(Qg + 16 * d0 + 8 * hi);
    const float* cum = CUM + (size_t)bh * SEQ; const float* tot = TOT + bh * 32;
    const float cq = cum[t0 + r32];
    LAS float* wsf = (LAS float*)(wl + WL_WSF);
    LAS float* wcum = (LAS float*)(wl + WL_CUM);
    float m = 0.f, l = 0.f, Doff = 0.f; f32x16 o[2]; o[0] = f32x16{}; o[1] = f32x16{};
    const bf16_t* Kb = PROJ + rowb * NP + C_KB + h * 64; const bf16_t* Vb = PROJ + rowb * NP + C_VB + h * 64;
    int s0 = t0 & ~63, ucur = t0 >> 8; bool first = true;
    TileRegs R; float cl, tn = 0.f; int un = ucur;
    issue_tile<true>(R, Kb + (size_t)s0 * NP, Vb + (size_t)s0 * NP, lane); cl = cum[s0 + lane];
    for (;;) {
        Doff += tn; ucur = un;
        if (!first) { const float c_last = __builtin_amdgcn_readlane(cl, 63); if (__all(zmax2 + cq - c_last + Doff - m < FOX_CUT)) break; }
        store_tile<true>(wl, R, lane); wcum[lane] = cl;
        if (s0 >= 64) { const int s1 = s0 - 64; issue_tile<true>(R, Kb + (size_t)s1 * NP, Vb + (size_t)s1 * NP, lane); cl = cum[s1 + lane]; un = s1 >> 8; tn = (un != ucur) ? tot[un] : 0.f;
 }
        __builtin_amdgcn_sched_barrier(0);
        f32x16 p0, p1; const float cb = cq + Doff - m;
#pragma unroll
        for (int j = 0; j < 4; ++j) { const f32x4 c0 = *(const LAS f32x4*)(wcum + 8 * j + 4 * hi), c1 = *(const LAS f32x4*)(wcum + 32 + 8 * j + 4 * hi);
#pragma unroll
            for (int e = 0; e < 4; ++e) { p0[4 * j + e] = cb - c0[e]; p1[4 * j + e] = cb - c1[e]; } }
        qk(p0, p1, wl, qr, r32, hi);
        if (first) { const int t = t0 + r32;
#pragma unroll
            for (int r = 0; r < 16; ++r) { const int key = s0 + crow(r, hi); if (key > t) p0[r] = -INFINITY; if (key + 32 > t) p1[r] = -INFINITY; } }
        float rm = fmaxf(p0[0], p1[0]);
#pragma unroll
        for (int r = 1; r < 16; ++r) rm = fmaxf(rm, fmaxf(p0[r], p1[r]));
        rm = swap_max(rm);
        if (first || __any(rm > 0.f)) {
            const float dl = first ? rm : fmaxf(rm, 0.f); m += dl;
            const float sc = ex2(-dl); l *= sc; if (hi == 0) wsf[r32] = sc;
#pragma unroll
            for (int r = 0; r < 16; ++r) { p0[r] -= dl; p1[r] -= dl; }
            if (!first) {
#pragma unroll
                for (int r = 0; r < 16; ++r) { const float f = wsf[crow(r, hi)]; o[0][r] *= f; o[1][r] *= f; } }
        }
        float ls = 0.f;
#pragma unroll
        for (int r = 0; r < 16; ++r) { p0[r] = ex2(p0[r]); p1[r] = ex2(p1[r]); ls += p0[r] + p1[r]; }
        l += ls;
        u32x4 pw[4]; pack_p(pw, p0, p1);
        pv(o, wl, lane, hi, pw);
        if (s0 == 0) break;
        s0 -= 64; first = false;
    }
    float dummy; l = swap_sum(l, dummy, hi);
    if (hi == 0) wsf[32 + r32] = __builtin_amdgcn_rcpf(l);
#pragma unroll
    for (int r = 0; r < 16; ++r) { const float f = wsf[32 + crow(r, hi)]; o[0][r] *= f; o[1][r] *= f; }
    emit_o(o, wl, lane, r32, hi, MIX + (rowb + t0) * DM + 256 + h * 64, nullptr);
}

__device__ __forceinline__ void sb_item(LAS unsigned char* wl, int lane, const bf16_t* PROJ, bf16_t* MIX, int bh, int qblk) {
    const int r32 = lane & 31, hi = lane >> 5, b = bh >> 2, h = bh & 3, t0 = qblk * 32;
    const size_t rowb = (size_t)b * SEQ;
    const bf16_t* Qg = PROJ + (rowb + t0 + r32) * NP + C_QA + h * 64;
    bf16x8 qr[4];
#pragma unroll
    for (int d0 = 0; d0 < 4; ++d0) qr[d0] = *(const bf16x8*)(Qg + 16 * d0 + 8 * hi);
    float R = 0.f; f32x16 o[2]; o[0] = f32x16{}; o[1] = f32x16{};
    const bf16_t* Kb = PROJ + rowb * NP + C_KA + h * 64; const bf16_t* Vb = PROJ + rowb * NP + C_VA + h * 64;
    int s0 = t0 & ~63; bool first = true;
    for (;;) {
        if (!first && __all(R < ZERO_CUT)) break;
        load_tile<true>(wl, Kb + (size_t)s0 * NP, Vb + (size_t)s0 * NP, lane);
        f32x16 p0 = f32x16{}, p1 = f32x16{};
        qk(p0, p1, wl, qr, r32, hi);
        f32x16 L0, L1; const int t = t0 + r32;
#pragma unroll
        for (int r = 0; r < 16; ++r) {
            const float s0p = softplus2(p0[r]), s1p = softplus2(p1[r]);
            L0[r] = -s0p; L1[r] = -s1p; p0[r] -= s0p; p1[r] -= s1p;
            if (first) { const int key = s0 + crow(r, hi); if (key >= t) { L0[r] = 0.f; p0[r] = -INFINITY; } if (key + 32 >= t) { L1[r] = 0.f; p1[r] = -INFINITY; } }
        }
        float T[8], PG[8];
#pragma unroll
        for (int j = 0; j < 4; ++j) {
            const float g0 = (L0[4 * j] + L0[4 * j + 1]) + (L0[4 * j + 2] + L0[4 * j + 3]), g1 = (L1[4 * j] + L1[4 * j + 1]) + (L1[4 * j + 2] + L1[4 * j + 3]);
            T[j] = swap_sum(g0, PG[j], hi); T[4 + j] = swap_sum(g1, PG[4 + j], hi);
        }
        float acc = 0.f, Suf[8];
#pragma unroll
        for (int j = 7; j >= 0; --j) { Suf[j] = acc + (hi == 0 ? PG[j] : 0.f); acc += T[j]; }
#pragma unroll
        for (int j = 0; j < 4; ++j) {
            { const float b3 = R + Suf[j], b2 = b3 + L0[4 * j + 3], b1 = b2 + L0[4 * j + 2], b0 = b1 + L0[4 * j + 1];
              p0[4 * j] = ex2(p0[4 * j] + b0); p0[4 * j + 1] = ex2(p0[4 * j + 1] + b1); p0[4 * j + 2] = ex2(p0[4 * j + 2] + b2); p0[4 * j + 3] = ex2(p0[4 * j + 3] + b3); }
            { const float b3 = R + Suf[4 + j], b2 = b3 + L1[4 * j + 3], b1 = b2 + L1[4 * j + 2], b0 = b1 + L1[4 * j + 1];
              p1[4 * j] = ex2(p1[4 * j] + b0); p1[4 * j + 1] = ex2(p1[4 * j + 1] + b1); p1[4 * j + 2] = ex2(p1[4 * j + 2] + b2); p1[4 * j + 3] = ex2(p1[4 * j + 3] + b3); }
        }
        R += acc;
        u32x4 pw[4]; pack_p(pw, p0, p1);
        pv(o, wl, lane, hi, pw);
        if (s0 == 0) break;
        s0 -= 64; first = false;
    }
    emit_o(o, wl, lane, r32, hi, MIX + (rowb + t0) * DM + h * 64, nullptr);
}

__device__ __forceinline__ void sgu_item(LAS unsigned char* wl, int lane, const bf16_t* PROJ, bf16_t* MIX, const float* sw  , const float* sbias  , int b, int chunk, int g, int tq) {
    const int r32 = lane & 31, hi = lane >> 5;
    const size_t row0 = (size_t)b * SEQ + chunk * 128;
    const int t = tq * 32 + r32;
    const float* wrow = sw + ((size_t)g * 128 + t) * 128;
    f32x16 o[2]; o[0] = f32x16{}; o[1] = f32x16{};
    for (int kt = 0; kt <= (tq >> 1); ++kt) {
        load_tile<false>(wl, nullptr, PROJ + (row0 + kt * 64) * NP + C_VC + g * 64, lane);
        u32x4 pw[4];
#pragma unroll
        for (int ks = 0; ks < 4; ++ks) { const int kb = kt * 64 + ks * 16 + 4 * hi;
            f32x4 a = *(const f32x4*)(wrow + kb), c = *(const f32x4*)(wrow + kb + 8);
#pragma unroll
            for (int e = 0; e < 4; ++e) { if (kb + e > t) a[e] = 0.f; if (kb + 8 + e > t) c[e] = 0.f; }
            pw[ks] = (u32x4){cvt_pk_bf16(a[0], a[1]), cvt_pk_bf16(a[2], a[3]), cvt_pk_bf16(c[0], c[1]), cvt_pk_bf16(c[2], c[3])}; }
        pv(o, wl, lane, hi, pw);
    }
#pragma unroll
    for (int r = 0; r < 16; ++r) { const float bb = sbias[g * 128 + tq * 32 + crow(r, hi)]; o[0][r] += bb; o[1][r] += bb; }
    emit_o(o, wl, lane, r32, hi, MIX + (row0 + tq * 32) * DM + 768 + g * 64, PROJ + (row0 + tq * 32) * NP + C_UC + g * 64);
}

__device__ __forceinline__ void mixers_phase(const Params& p, int l, LAS unsigned char* lds, int tid) {
    const int lane = tid & 63, wid = __builtin_amdgcn_readfirstlane(tid >> 6);
    LAS unsigned char* wl = lds + wid * WL_BYTES;
    const bf16_t* PROJ = (const bf16_t*)(p.ws + WS_PROJ); bf16_t* MIX = (bf16_t*)(p.ws + WS_MIX);
    const float* CUM = (const float*)(p.ws + WS_CUM); const float* TOT = (const float*)(p.ws + WS_TOT);
    const float gq = wave_max(fabsf(p.q_norm_g[l * 64 + lane])), gk = wave_max(fabsf(p.k_norm_g[l * 64 + lane]));
    const float zmax2 = 64.f * C2 * gq * gk * 1.02f;
    unsigned horder = 0;
    { float bfv[8];
#pragma unroll
      for (int h = 0; h < 8; ++h) bfv[h] = p.b_forget[l * 8 + h];
#pragma unroll
      for (int h = 0; h < 8; ++h) { int rank = 0;
#pragma unroll
          for (int g = 0; g < 8; ++g) rank += (bfv[g] > bfv[h] || (bfv[g] == bfv[h] && g < h)) ? 1 : 0;
          horder |= (unsigned)h << (4 * rank); } }
    const unsigned x0 = xb_xcc_id() & 7u;
#pragma unroll 1
    for (unsigned k = 0; k < 8u; ++k) {
        const unsigned q = (x0 + k) & 7u; unsigned* ctr = (unsigned*)(p.ws + WS_CTL) + (l * 8 + (int)q) * 64;
        if (k) { unsigned seen = 0; if (lane == 0) seen = __hip_atomic_load(ctr, __ATOMIC_RELAXED, __HIP_MEMORY_SCOPE_AGENT); if ((unsigned)__builtin_amdgcn_readfirstlane(seen) >= 1024u) continue; }
        unsigned j = 0; if (lane == 0) j = __hip_atomic_fetch_add(ctr, 1u, __ATOMIC_RELAXED, __HIP_MEMORY_SCOPE_AGENT);
        j = __builtin_amdgcn_readfirstlane(j);
        while (j < 1024u) {
            unsigned jn = 0; if (lane == 0) jn = __hip_atomic_fetch_add(ctr, 1u, __ATOMIC_RELAXED, __HIP_MEMORY_SCOPE_AGENT);
            if (j < 512u) { const unsigned slot = j >> 5, hh = (horder >> (4u * (slot >> 1))) & 7u; fox_item(wl, lane, PROJ, MIX, CUM, TOT, zmax2, (int)((slot & 1u) * 8u + hh), (int)(32u * q + 31u - (j & 31u))); }
            else if (j < 768u) { const unsigned jj = j - 512u; sb_item(wl, lane, PROJ, MIX, (int)(jj >> 5), (int)(32u * q + 31u - (jj & 31u))); }
            else { const unsigned jj = j - 768u, bc = 16u * q + (jj >> 4); sgu_item(wl, lane, PROJ, MIX, p.sgu_w + (size_t)l * 4 * 128 * 128, p.sgu_b + (size_t)l * 4 * 128, (int)(bc >> 6), (int)(bc & 63u), (int)((jj >> 2) & 3u), 3 - (int)(jj & 3u)); }
            j = __builtin_amdgcn_readfirstlane(jn);
        }
    }
}
__device__ __forceinline__ int bt_row(int a) { return (a & ~255) + 128 * ((a >> 5) & 1) + 32 * ((a >> 6) & 3) + (a & 31); }

__device__ __forceinline__ void gemv2_item(const float* W, int ldw, int N, int n0, const float* vec, int vstride, bool do_silu, const float* bias, float* out, int ostride, int mode, float* cf_out, LAS float* red, int tid) {
    const int cgp = tid & 15, kg = tid >> 4, n = n0 + 4 * cgp;
    f32x4 a0 = {0.f, 0.f, 0.f, 0.f}, a1 = {0.f, 0.f, 0.f, 0.f};
    if (n < N) {
#pragma unroll 8
        for (int i = 0; i < 32; ++i) { const int k = kg * 32 + i;
            float v0 = vec[k], v1 = vec[vstride + k];
            if (do_silu) { v0 = v0 * __builtin_amdgcn_rcpf(1.f + ex2(-LOG2E * v0)); v1 = v1 * __builtin_amdgcn_rcpf(1.f + ex2(-LOG2E * v1)); }
            const f32x4 w = *(const f32x4*)(W + (size_t)k * ldw + n);
            a0 += w * v0; a1 += w * v1; }
    }
    *(LAS f32x4*)(red + (kg * 2 + 0) * 64 + 4 * cgp) = a0; *(LAS f32x4*)(red + (kg * 2 + 1) * 64 + 4 * cgp) = a1;
    __syncthreads();
    if (tid < 128) { const int b = tid >> 6, c = tid & 63, nn = n0 + c;
        if (nn < N) { float s = 0.f;
#pragma unroll 8
            for (int g = 0; g < 32; ++g) s += red[(g * 2 + b) * 64 + c];
            if (bias) s += bias[nn];
            if (mode == 0) out[b * ostride + nn] = s;
            else { if (nn < 2304) out[b * ostride + nn] = s; else if (nn < 2312) cf_out[b * 8 + nn - 2304] = s; else out[b * ostride + nn - 8] = s; } } }
    __syncthreads();
}

__device__ __forceinline__ void transpose_item(const float* W, int ldw, int K, int k0, int ncol0  , bf16_t* Bt0, bf16_t* Bt1  , int drow0  ,
                                               const LAS float* als  , LAS float* scr, int lane) {
    float tv[32];
#pragma unroll
    for (int i = 0; i < 32; ++i) { const int kk = 2 * i + (lane >> 5); tv[i] = W[(size_t)(k0 + kk) * ldw + ncol0 + (lane & 31)]; }
#pragma unroll
    for (int i = 0; i < 32; ++i) { const int kk = 2 * i + (lane >> 5); scr[kk * 33 + (lane & 31)] = tv[i]; }
    const int c = lane & 7;
    float s0[8], s1[8];
#pragma unroll
    for (int e = 0; e < 8; ++e) { s0[e] = als ? als[8 * c + e] : 1.f; s1[e] = als ? als[64 + 8 * c + e] : 1.f; }
#pragma unroll
    for (int j = 0; j < 4; ++j) { const int n = (lane >> 3) + 8 * j; const LAS float* s = scr + (8 * c) * 33 + n;
        float v[8];
#pragma unroll
        for (int e = 0; e < 8; ++e) v[e] = s[e * 33];
        u32x4 o; o.x = cvt_pk_bf16(v[0] * s0[0], v[1] * s0[1]); o.y = cvt_pk_bf16(v[2] * s0[2], v[3] * s0[3]); o.z = cvt_pk_bf16(v[4] * s0[4], v[5] * s0[5]); o.w = cvt_pk_bf16(v[6] * s0[6], v[7] * s0[7]);
        *(u32x4*)(Bt0 + (size_t)(drow0 + n) * K + k0 + 8 * c) = o;
        if (Bt1) { u32x4 q; q.x = cvt_pk_bf16(v[0] * s1[0], v[1] * s1[1]); q.y = cvt_pk_bf16(v[2] * s1[2], v[3] * s1[3]); q.z = cvt_pk_bf16(v[4] * s1[4], v[5] * s1[5]); q.w = cvt_pk_bf16(v[6] * s1[6], v[7] * s1[7]);
            *(u32x4*)(Bt1 + (size_t)(drow0 + n) * K + k0 + 8 * c) = q; } }
}

__device__ __forceinline__ void p0_phase(const Params& p, LAS unsigned char* lds, int tid) {
    const int lane = tid & 63, wid = __builtin_amdgcn_readfirstlane(tid >> 6);
    float* MOD = (float*)(p.ws + WS_MOD);
    for (int it = blockIdx.x; it < DEPTH * 96; it += gridDim.x) { const int l = it / 96, nb = it % 96;
        gemv2_item(p.ada_w + (size_t)l * DM * 6144, 6144, 6144, nb * 64, p.c, DM, true, p.ada_b + l * 6144, MOD + (size_t)l * 2 * 6144, 6144, 0, nullptr, (LAS float*)lds, tid); }
    LAS float* scr = (LAS float*)(lds + wid * 16384);
    const int gw = blockIdx.x * NWAVES + wid, NGW = gridDim.x * NWAVES;
    bf16_t* WOUT = (bf16_t*)(p.ws + WS_WOUT); bf16_t* W2 = (bf16_t*)(p.ws + WS_W2);
    constexpr int I_O = (DM / 64) * (DM / 32), I_2 = (FF / 64) * (DM / 32), I_L = I_O + I_2;
    for (int it = gw; it < DEPTH * I_L; it += NGW) { const int l = it / I_L; int r = it % I_L;
        if (r < I_O) { const int kb = r / 32, nb = r % 32; transpose_item(p.w_out + (size_t)l * DM * DM, DM, DM, kb * 64, nb * 32, WOUT + (size_t)l * DM * DM, nullptr, bt_row(nb * 32), nullptr, scr, lane); }
        else { r -= I_O; const int kb = r / 32, nb = r % 32; transpose_item(p.mlp_w2 + (size_t)l * FF * DM, DM, FF, kb * 64, nb * 32, W2 + (size_t)l * DM * FF, nullptr, bt_row(nb * 32), nullptr, scr, lane); } }
    bf16_t* XB = (bf16_t*)(p.ws + WS_XB); float* SS = (float*)(p.ws + WS_SS);
    for (int row = gw; row < M; row += NGW) {
        const f32x4* xr = (const f32x4*)(p.x + (size_t)row * DM) + lane; float s = 0.f; f32x4 v[4];
#pragma unroll
        for (int j = 0; j < 4; ++j) { v[j] = xr[64 * j]; s += (v[j][0] * v[j][0] + v[j][1] * v[j][1]) + (v[j][2] * v[j][2] + v[j][3] * v[j][3]); }
        s = wave_sum(s);
        u32x2* o8 = (u32x2*)(XB + (size_t)row * DM) + lane;
#pragma unroll
        for (int j = 0; j < 4; ++j) o8[64 * j] = (u32x2){cvt_pk_bf16(v[j][0], v[j][1]), cvt_pk_bf16(v[j][2], v[j][3])};
        if (lane < 4) SS[(size_t)lane * M + row] = lane == 0 ? s : 0.f;
    }
}

__device__ __forceinline__ void p1_phase(const Params& p, LAS unsigned char* lds, int tid) {
    const int lane = tid & 63, wid = __builtin_amdgcn_readfirstlane(tid >> 6);
    const float* MOD = (const float*)(p.ws + WS_MOD);
    float* CIN = (float*)(p.ws + WS_CIN); float* C1 = (float*)(p.ws + WS_C1); float* CF = (float*)(p.ws + WS_CF); float* WF = (float*)(p.ws + WS_WF);
    for (int it = blockIdx.x; it < DEPTH * (45 + 64); it += gridDim.x) { const int l = it / 109, r = it % 109;
        if (r < 45) gemv2_item(p.w_in + (size_t)l * DM * INW, INW, INW, r * 64, MOD + (size_t)l * 2 * 6144, 6144, false, nullptr, CIN + (size_t)l * 2 * NP, NP, 1, CF + l * 16, (LAS float*)lds, tid);
        else gemv2_item(p.mlp_w1 + (size_t)l * DM * FF, FF, FF, (r - 45) * 64, MOD + (size_t)l * 2 * 6144 + 3072, 6144, false, nullptr, C1 + (size_t)l * 2 * FF, FF, 0, nullptr, (LAS float*)lds, tid); }
    for (int i = blockIdx.x * NTHREADS + tid; i < DEPTH * 2 * 8 * DM; i += gridDim.x * NTHREADS) {
        const int k = i & 1023, h = (i >> 10) & 7, b = (i >> 13) & 1, l = i >> 14;
        const float al = p.norm1_g[l * DM + k] * (1.f + MOD[((size_t)l * 2 + b) * 6144 + 1024 + k]);
        { const float wv = al * p.w_in[((size_t)l * DM + k) * INW + 2304 + h]; const float nb = __shfl_down(wv, 1); if (!(k & 1)) ((unsigned*)WF)[i >> 1] = cvt_pk_bf16(wv, nb); }
    }
    __syncthreads();
    LAS float* scr = (LAS float*)(lds + wid * 16384);
    LAS float* als = scr + 64 * 33;
    const int gw = blockIdx.x * NWAVES + wid, NGW = gridDim.x * NWAVES;
    bf16_t* WIN = (bf16_t*)(p.ws + WS_WIN); bf16_t* W1 = (bf16_t*)(p.ws + WS_W1);
    constexpr int I_I = (DM / 64) * (NP / 32), I_1 = (DM / 64) * (FF / 32), I_L = I_I + I_1;
    for (int it = gw; it < DEPTH * I_L; it += NGW) { const int l = it / I_L; int r = it % I_L;
        const bool isin = r < I_I; if (!isin) r -= I_I;
        const int nblk = isin ? NP / 32 : FF / 32, kb = r / nblk, nb = r % nblk, k0 = kb * 64;
        { const float g = isin ? p.norm1_g[l * DM + k0 + lane] : p.norm2_g[l * DM + k0 + lane]; const int so = isin ? 1024 : 4096;
          als[lane] = g * (1.f + MOD[((size_t)l * 2 + 0) * 6144 + so + k0 + lane]); als[64 + lane] = g * (1.f + MOD[((size_t)l * 2 + 1) * 6144 + so + k0 + lane]); }
        if (isin) { const int cc = nb * 32, src = cc < 2304 ? cc : cc + 8;
            transpose_item(p.w_in + (size_t)l * DM * INW, INW, DM, k0, src, WIN + ((size_t)l * 2 + 0) * NP * DM, WIN + ((size_t)l * 2 + 1) * NP * DM, bt_row(cc), als, scr, lane); }
        else transpose_item(p.mlp_w1 + (size_t)l * DM * FF, FF, DM, k0, nb * 32, W1 + ((size_t)l * 2 + 0) * FF * DM, W1 + ((size_t)l * 2 + 1) * FF * DM, bt_row(nb * 32), als, scr, lane);
    }
}
__device__ __forceinline__ void fl_unit(const Params& p, int l, int unit, LAS unsigned char* lds, int tid) {
    const int lane = tid & 63, wid = __builtin_amdgcn_readfirstlane(tid >> 6), r32 = lane & 31, hi = lane >> 5;
    const int b = unit >> 5, row0 = unit * 256;
    const bf16_t* XB = (const bf16_t*)(p.ws + WS_XB); const float* SS = (const float*)(p.ws + WS_SS);
    const bf16_t* WFB = (const bf16_t*)(p.ws + WS_WF) + ((size_t)l * 2 + b) * 8 * DM; const float* CF = (const float*)(p.ws + WS_CF) + l * 16 + b * 8;
    float* CUM = (float*)(p.ws + WS_CUM); float* TOT = (float*)(p.ws + WS_TOT);
    LAS float* accs = (LAS float*)lds;
    LAS float* lf = accs + 2048;
    {
        const bf16_t* xrow = XB + (size_t)(row0 + wid * 32 + r32) * DM + 8 * hi;
        const bf16_t* wrow = WFB + (size_t)(r32 & 7) * DM + 8 * hi;
        f32x16 acc = f32x16{};
#pragma unroll 8
        for (int ks = 0; ks < 64; ++ks) {
            const bf16x8 a = *(const bf16x8*)(xrow + 16 * ks);
            bf16x8 w = *(const bf16x8*)(wrow + 16 * ks);
            if (r32 >= 8) w = bf16x8{};
            acc = mfma32(a, w, acc);
        }
        if (r32 < 8) {
#pragma unroll
            for (int r = 0; r < 16; ++r) accs[(wid * 32 + crow(r, hi)) * 8 + r32] = acc[r];
        }
    }
    __syncthreads();
    if (tid < 256) { const float rs = rstd_row(SS, row0 + tid);
#pragma unroll
        for (int h = 0; h < 8; ++h) { const float v = rs * accs[tid * 8 + h] + CF[h] + p.b_forget[l * 8 + h]; const float y = v * LOG2E;
            lf[h * 256 + tid] = -(fmaxf(-y, 0.f) + lg2(1.f + ex2(-fabsf(y)))); } }
    __syncthreads();
    { const int h = wid; f32x4 v = *(const LAS f32x4*)(lf + h * 256 + 4 * lane);
      v[1] += v[0]; v[2] += v[1]; v[3] += v[2];
      float run = v[3];
#pragma unroll
      for (int o = 1; o < 64; o <<= 1) { const float t = __shfl_up(run, o); if (lane >= o) run += t; }
      const float ex = run - v[3]; v = v + ex;
      const int bh = b * 8 + h;
      *(f32x4*)(CUM + (size_t)bh * SEQ + (row0 - b * SEQ) + 4 * lane) = v;
      if (lane == 63) TOT[bh * 32 + (unit & 31)] = run; }
    __syncthreads();
}

#ifndef DBG_STOP
#define DBG_STOP 0
#endif
__device__ __forceinline__ float bf2f(bf16_t v) { return __uint_as_float((unsigned)v << 16); }
__device__ __forceinline__ void dbg_dump(const Params& p, int stage) {
    const bf16_t* XB = (const bf16_t*)(p.ws + WS_XB); const bf16_t* PROJ = (const bf16_t*)(p.ws + WS_PROJ); const bf16_t* MIX = (const bf16_t*)(p.ws + WS_MIX); const bf16_t* HID = (const bf16_t*)(p.ws + WS_HID);
    const float* MOD = (const float*)(p.ws + WS_MOD); const float* CUM = (const float*)(p.ws + WS_CUM); const float* SS = (const float*)(p.ws + WS_SS);
    const bf16_t* WIN = (const bf16_t*)(p.ws + WS_WIN); const bf16_t* W1 = (const bf16_t*)(p.ws + WS_W1); const bf16_t* WOUT = (const bf16_t*)(p.ws + WS_WOUT); const bf16_t* W2 = (const bf16_t*)(p.ws + WS_W2);
    const float* CIN = (const float*)(p.ws + WS_CIN); const float* C1 = (const float*)(p.ws + WS_C1); const float* WF = (const float*)(p.ws + WS_WF);
    for (size_t i = (size_t)blockIdx.x * NTHREADS + threadIdx.x; i < (size_t)M * DM; i += (size_t)gridDim.x * NTHREADS) {
        const size_t m = i >> 10, n = i & 1023; float v = 0.f;
        if (stage == 1) v = bf2f(XB[i]) + MOD[i % 49152] + bf2f(WIN[i]) + bf2f(WIN[i + 16777216]) + bf2f(W1[i]) + bf2f(W1[i + 16777216]) + bf2f(WOUT[i % 4194304]) + bf2f(W2[i]) + CIN[i % 22528] + C1[i % 32768] + WF[i % 65536] + SS[i % 65536];
        if (stage == 2) v = bf2f(PROJ[m * NP + n]) + bf2f(PROJ[m * NP + 1024 + n]) + bf2f(PROJ[m * NP + 1792 + n]) + CUM[i % 131072];
        if (stage == 3) v = bf2f(MIX[i]);
        if (stage == 4) v = p.out[i] + bf2f(XB[i]) + SS[i % 65536];
        if (stage == 5) v = bf2f(HID[m * FF + n]) + bf2f(HID[m * FF + 1024 + n]) + bf2f(HID[m * FF + 2048 + n]) + bf2f(HID[m * FF + 3072 + n]);
        p.out[i] = v;
    }
}

__global__ void __launch_bounds__(NTHREADS, 2) fwd_megakernel(Params p) {
    extern __shared__ __attribute__((aligned(16))) unsigned char lds_raw[];
    LAS unsigned char* lds = (LAS unsigned char*)lds_raw;
    cg::grid_group grid = cg::this_grid();
    const int G = gridDim.x;
#ifndef PA_ALIGN
#define PA_ALIGN true
#endif
#ifndef PC2_ALIGN
#define PC2_ALIGN true
#endif
#ifndef REP_SYNC
#define REP_SYNC 1
#endif
#ifndef REP_PB
#define REP_PB 1
#endif
#ifndef REP_PRO
#define REP_PRO 1
#endif
#ifndef REP_PA
#define REP_PA 1
#endif
#define GRID_SYNC() do { for (int r_ = 0; r_ < REP_SYNC; ++r_) { xcd_barrier(xbar); } } while (0)
#define FRESH_TID() int tid = threadIdx.x; asm volatile("" : "+v"(tid))
    float* MOD = (float*)(p.ws + WS_MOD); float* SS = (float*)(p.ws + WS_SS);
    bf16_t* XB = (bf16_t*)(p.ws + WS_XB); bf16_t* PROJ = (bf16_t*)(p.ws + WS_PROJ); bf16_t* MIX = (bf16_t*)(p.ws + WS_MIX); bf16_t* HID = (bf16_t*)(p.ws + WS_HID);

    if (blockIdx.x == 0) for (int i = threadIdx.x; i < CTL_WORDS / 32; i += NTHREADS) __hip_atomic_store((unsigned*)(p.ws + WS_CTL) + 32 * i, 0u, __ATOMIC_RELAXED, __HIP_MEMORY_SCOPE_AGENT);
    volatile LAS unsigned* misc = (volatile LAS unsigned*)(lds + LDS_MISC);
    if (threadIdx.x < 2) misc[threadIdx.x] = 0u;
    asm volatile("s_waitcnt vmcnt(0)" ::: "memory"); __syncthreads(); grid.sync();
    XcdBarrier xbar = xcd_barrier_post((unsigned*)(p.ws + WS_CTL) + CW_BAR, misc);
    for (int r_ = 0; r_ < REP_PRO; ++r_) {
    { FRESH_TID(); p0_phase(p, lds, tid); }
    GRID_SYNC();
    { FRESH_TID(); p1_phase(p, lds, tid); }
    GRID_SYNC();
    }
    if (DBG_STOP == 1) { dbg_dump(p, 1); return; }

#pragma unroll 1
    for (int l = 0; l < DEPTH; ++l) {
        {
            pg8::Gemm g{XB, (const bf16_t*)(p.ws + WS_WIN) + (size_t)l * 2 * NP * DM, M, NP, DM, (size_t)NP * DM * 2};
            pg8::StaticOrder S; S.init(M, NP, G, (int)blockIdx.x);
            EpiIn E{PROJ, SS, (const float*)(p.ws + WS_CIN) + (size_t)l * 2 * NP, p.q_norm_g + l * 64, p.k_norm_g + l * 64, p.sgu_norm_g + l * 256};
            for (int r_ = 0; r_ < REP_PA; ++r_) { pg8::gemm_phase<EpiIn, pg8::StaticOrder, PA_ALIGN, true>(lds, g, S, E); __syncthreads(); }
            __syncthreads();
            const int nunits = (M / 256) * (NP / 256);
            const int first_light = nunits % G;
            for (int u = (int)blockIdx.x - first_light; u >= 0 && u < 64; u += (G - first_light)) {
#ifndef NO_FL
                { FRESH_TID(); fl_unit(p, l, u, lds, tid); }
#endif
            }
        }
        GRID_SYNC();
        if (DBG_STOP == 2) { dbg_dump(p, 2); return; }
#ifndef NO_PB
        for (int r_ = 0; r_ < REP_PB; ++r_) { if (r_) { if (blockIdx.x == 0 && threadIdx.x < 8) { __hip_atomic_store((unsigned*)(p.ws + WS_CTL) + 64 * (l * 8 + threadIdx.x), 0u, __ATOMIC_RELAXED, __HIP_MEMORY_SCOPE_AGENT); __hip_atomic_store((unsigned*)(p.ws + WS_CTL) + 64 * (32 + l * 8 + threadIdx.x), 0u, __ATOMIC_RELAXED, __HIP_MEMORY_SCOPE_AGENT); } GRID_SYNC(); } FRESH_TID(); mixers_phase(p, l, lds, tid); if (r_ + 1 < REP_PB) GRID_SYNC(); }
#endif
        GRID_SYNC();
        if (DBG_STOP == 3) { dbg_dump(p, 3); return; }
        {
            pg8::Gemm g{MIX, (const bf16_t*)(p.ws + WS_WOUT) + (size_t)l * DM * DM, M, DM, DM, 0};
            pg8::StaticOrder S; S.init(M, DM, G, (int)blockIdx.x);
            EpiRes E{l == 0 ? p.x : p.out, p.out, XB, SS, MOD + (size_t)l * 2 * 6144 + 2048};
#ifndef NO_PC1
            if (G == 256) pg8::gemm_phase<EpiRes, pg8::StaticOrder, false, true>(lds, g, S, E);
#endif
        }
        GRID_SYNC();
        if (DBG_STOP == 4) { dbg_dump(p, 4); return; }
        {
            pg8::Gemm g{XB, (const bf16_t*)(p.ws + WS_W1) + (size_t)l * 2 * FF * DM, M, FF, DM, (size_t)FF * DM * 2};
            pg8::StaticOrder S; S.init(M, FF, G, (int)blockIdx.x);
            EpiUp E{HID, SS, (const float*)(p.ws + WS_C1) + (size_t)l * 2 * FF};
#ifndef NO_PC2
            pg8::gemm_phase<EpiUp, pg8::StaticOrder, PC2_ALIGN, true>(lds, g, S, E);
#endif
        }
        GRID_SYNC();
        if (DBG_STOP == 5) { dbg_dump(p, 5); return; }
        {
            pg8::Gemm g{HID, (const bf16_t*)(p.ws + WS_W2) + (size_t)l * DM * FF, M, DM, FF, 0};
            pg8::StaticOrder S; S.init(M, DM, G, (int)blockIdx.x);
            EpiRes E{p.out, p.out, XB, SS, MOD + (size_t)l * 2 * 6144 + 5120};
#ifndef NO_PC3
            if (G == 256) pg8::gemm_phase<EpiRes, pg8::StaticOrder, false, true>(lds, g, S, E);
#endif
        }
        if (DBG_STOP == 6) return;
        if (l + 1 < DEPTH) GRID_SYNC();
    }
}

extern "C" void kernel_launch(void* const* d_in, const int* in_sizes, int n_in, void* d_out, int out_size, void* d_ws, size_t ws_size, hipStream_t stream) {
    static int grid_blocks = 0;
    if (grid_blocks == 0) {
        if (n_in != 16 || in_sizes[0] != M * DM || out_size != M * DM || ws_size < WS_END) { fprintf(stderr, "kernel_launch: unexpected shapes / workspace (%d inputs, ws %zu)\n", n_in, ws_size); grid_blocks = -1; return; }
        int dev = 0, cus = 0, per_cu = 0;
        hipGetDevice(&dev); hipDeviceGetAttribute(&cus, hipDeviceAttributeMultiprocessorCount, dev);
        if (hipFuncSetAttribute((const void*)fwd_megakernel, hipFuncAttributeMaxDynamicSharedMemorySize, LDS_BYTES) != hipSuccess) { fprintf(stderr, "kernel_launch: hipFuncSetAttribute failed\n"); grid_blocks = -1; return; }
        hipOccupancyMaxActiveBlocksPerMultiprocessor(&per_cu, (const void*)fwd_megakernel, NTHREADS, LDS_BYTES);
        (void)hipGetLastError();
        if (per_cu < 1) per_cu = 1;
        grid_blocks = cus;
        if (grid_blocks != 256) fprintf(stderr, "kernel_launch: %d CUs; the residual GEMM phases need a 256-workgroup grid\n", grid_blocks);
    }
    if (grid_blocks < 0) return;
    Params p{};
    p.x = (const float*)d_in[0]; p.c = (const float*)d_in[1]; p.ada_w = (const float*)d_in[2]; p.ada_b = (const float*)d_in[3]; p.norm1_g = (const float*)d_in[4]; p.norm2_g = (const float*)d_in[5];
    p.w_in = (const float*)d_in[6]; p.b_forget = (const float*)d_in[7]; p.q_norm_g = (const float*)d_in[8]; p.k_norm_g = (const float*)d_in[9]; p.sgu_norm_g = (const float*)d_in[10];
    p.sgu_w = (const float*)d_in[11]; p.sgu_b = (const float*)d_in[12]; p.w_out = (const float*)d_in[13]; p.mlp_w1 = (const float*)d_in[14]; p.mlp_w2 = (const float*)d_in[15];
    p.out = (float*)d_out; p.ws = (unsigned char*)d_ws;
    void* args[] = {&p};
    hipError_t e = hipLaunchCooperativeKernel((const void*)fwd_megakernel, dim3(grid_blocks), dim3(NTHREADS), args, LDS_BYTES, stream);
    if (e != hipSuccess) fprintf(stderr, "cooperative launch failed: %s (grid %d)\n", hipGetErrorString(e), grid_blocks);
}
```
